# Optimizing an MI355X kernel written in HIP

```python
import math
import jax
import jax.numpy as jnp
from jax import lax
import numpy as np

D_MODEL = 1024
BATCH = 8
SEQ = 4096
DEPTH = 2

CTX_LEN = 256
GRID_W = 64
Q_BLOCK = 128
ROPE_BASE = 10000.0
HEAD_DIM = 64
N_BRANCH = 4
BRANCH_W = D_MODEL // N_BRANCH

MLA_HEADS = 4
MLA_Q_LORA = D_MODEL // 4
MLA_KV_LORA = D_MODEL // 8
MLA_NOPE = 64
MLA_ROPE = 32
MLA_V = 64
MLA_SCALE = (MLA_NOPE + MLA_ROPE) ** -0.5

RWKV_HEADS = 4
RWKV_N = 64
RWKV_DECAY_LORA = 64
RWKV_AAA_LORA = 64
RWKV_GN_EPS = 64e-5
RWKV_DECAY_SCALE = math.exp(-0.5)
RWKV_SPLITS = (BRANCH_W, BRANCH_W, BRANCH_W,
               RWKV_DECAY_LORA, RWKV_DECAY_LORA, RWKV_AAA_LORA, RWKV_AAA_LORA)
RWKV_SHIFT_W = sum(RWKV_SPLITS)

GQA_Q_HEADS = 4
GQA_KV_HEADS = 2
GQA_SCALE = HEAD_DIM ** -0.5

DIFF_HEADS = 4
DIFF_D = 32
DIFF_V = 64
DIFF_SCALE = DIFF_D ** -0.5

ALPHA = (2 * DEPTH) ** 0.25
BETA = (8 * DEPTH) ** -0.25

IN_SPLITS = (
    MLA_Q_LORA, MLA_KV_LORA, MLA_ROPE, BRANCH_W,
    RWKV_SHIFT_W, BRANCH_W,
    GQA_Q_HEADS * HEAD_DIM, GQA_KV_HEADS * HEAD_DIM, GQA_KV_HEADS * HEAD_DIM, BRANCH_W,
    DIFF_HEADS * 2 * DIFF_D, DIFF_HEADS * 2 * DIFF_D, DIFF_HEADS * DIFF_V, BRANCH_W,
    N_BRANCH * D_MODEL,
)
IN_W = sum(IN_SPLITS)

kernel_name = "hybrid_mla_rwkv7_gqa_diffattn_dit"


def split_cols(y, widths):
    out, o = [], 0
    for w in widths:
        out.append(y[..., o:o + w])
        o += w
    return out


def flat_heads(o):
    return o.reshape(o.shape[0], o.shape[1], -1)


def layer_norm(x, eps=1e-6):
    xf = x.astype(jnp.float32)
    mu = jnp.mean(xf, axis=-1, keepdims=True)
    var = jnp.mean(jnp.square(xf - mu), axis=-1, keepdims=True)
    return ((xf - mu) * lax.rsqrt(var + eps)).astype(x.dtype)


def post_norm(h, g, b):
    return layer_norm(h, 1e-5) * g + b


def rms_norm(x, g, eps):
    xf = x.astype(jnp.float32)
    return (xf * lax.rsqrt(jnp.mean(jnp.square(xf), axis=-1, keepdims=True) + eps)).astype(x.dtype) * g


def l2_normalize(t):
    tf = t.astype(jnp.float32)
    return (tf * lax.rsqrt(jnp.sum(jnp.square(tf), axis=-1, keepdims=True) + 1e-12)).astype(t.dtype)


def group_norm_heads(y, w, b):
    mu = jnp.mean(y, axis=-1, keepdims=True)
    var = jnp.mean(jnp.square(y - mu), axis=-1, keepdims=True)
    return ((y - mu) * lax.rsqrt(var + RWKV_GN_EPS)).astype(w.dtype) * w + b


def modulate(x, shift, scale):
    return layer_norm(x) * (1.0 + scale) + shift


def axial_rope_tables(row, col, rot_dim):
    quarter = rot_dim // 4
    inv_freq = ROPE_BASE ** (-jnp.arange(quarter, dtype=jnp.float32) / quarter)
    ang = jnp.concatenate([row[:, None] * inv_freq, col[:, None] * inv_freq], axis=-1)
    return jnp.cos(ang), jnp.sin(ang)


def apply_rope(t, cos, sin):
    half = t.shape[-1] // 2
    c = cos[:, None, :].astype(t.dtype)
    s = sin[:, None, :].astype(t.dtype)
    t1, t2 = t[..., :half], t[..., half:]
    return jnp.concatenate([t1 * c - t2 * s, t2 * c + t1 * s], axis=-1)


def sweep_query_blocks(fn, *qs):
    B, L = qs[0].shape[:2]
    nb = L // Q_BLOCK
    blocks = tuple(jnp.moveaxis(q.reshape(B, nb, Q_BLOCK, *q.shape[2:]), 1, 0) for q in qs)
    out = lax.map(lambda qb: fn(*qb), blocks)
    return jnp.moveaxis(out, 0, 1).reshape(B, L, *out.shape[3:])


def softmax_attention(q, k, v, scale):
    Hq, Hk = q.shape[2], k.shape[2]
    G = Hq // Hk

    def block(qb):
        Bq, Q = qb.shape[:2]
        qg = qb.reshape(Bq, Q, Hk, G, qb.shape[-1])
        s = jnp.einsum('bqhgd,bkhd->bhgqk', qg, k).astype(jnp.float32) * scale
        p = jax.nn.softmax(s, axis=-1).astype(v.dtype)
        o = jnp.einsum('bhgqk,bkhe->bqhge', p, v)
        return o.reshape(Bq, Q, Hq, v.shape[-1])

    return sweep_query_blocks(block, q)


def differential_attention(q1, q2, k1, k2, v, lam):
    def block(q1b, q2b):
        s1 = jnp.einsum('bqhd,bkhd->bhqk', q1b, k1).astype(jnp.float32) * DIFF_SCALE
        s2 = jnp.einsum('bqhd,bkhd->bhqk', q2b, k2).astype(jnp.float32) * DIFF_SCALE
        p = jax.nn.softmax(s1, axis=-1) - lam * jax.nn.softmax(s2, axis=-1)
        return jnp.einsum('bhqk,bkhe->bqhe', p.astype(v.dtype), v)

    return sweep_query_blocks(block, q1, q2)


def mla_project(q_lat, kv_lat, k_rope, q_norm, w_uq, kv_norm, w_ukv, rope):
    B, L = q_lat.shape[:2]
    q = (rms_norm(q_lat, q_norm, 1e-6) @ w_uq).reshape(B, L, MLA_HEADS, MLA_NOPE + MLA_ROPE)
    kv = (rms_norm(kv_lat, kv_norm, 1e-6) @ w_ukv).reshape(B, L, MLA_HEADS, MLA_NOPE + MLA_V)
    q_nope, q_pe = q[..., :MLA_NOPE], q[..., MLA_NOPE:]
    k_nope, v = kv[..., :MLA_NOPE], kv[..., MLA_NOPE:]
    k_pe = k_rope[:, :, None, :]
    if rope is not None:
        q_pe = apply_rope(q_pe, *rope)
        k_pe = apply_rope(k_pe, *rope)
    q = jnp.concatenate([q_nope, q_pe], axis=-1)
    k = jnp.concatenate([k_nope, jnp.broadcast_to(k_pe, (B, L, MLA_HEADS, MLA_ROPE))], axis=-1)
    return q, k, v


def gqa_project(q, k, v, q_norm, k_norm, rope):
    B, L = q.shape[:2]
    q = rms_norm(q.reshape(B, L, GQA_Q_HEADS, HEAD_DIM), q_norm, 1e-6)
    k = rms_norm(k.reshape(B, L, GQA_KV_HEADS, HEAD_DIM), k_norm, 1e-6)
    v = v.reshape(B, L, GQA_KV_HEADS, HEAD_DIM)
    if rope is not None:
        q = apply_rope(q, *rope)
        k = apply_rope(k, *rope)
    return q, k, v


def diff_project(q, k, v, rope):
    B, L = q.shape[:2]
    q = q.reshape(B, L, DIFF_HEADS, 2, DIFF_D)
    k = k.reshape(B, L, DIFF_HEADS, 2, DIFF_D)
    v = v.reshape(B, L, DIFF_HEADS, DIFF_V)
    q1, q2, k1, k2 = q[..., 0, :], q[..., 1, :], k[..., 0, :], k[..., 1, :]
    if rope is not None:
        q1, q2, k1, k2 = (apply_rope(t, *rope) for t in (q1, q2, k1, k2))
    return q1, q2, k1, k2, v


def centred_shift(t, mu_prev, mu_next):
    zero = jnp.zeros_like(t[:, :1])
    t_prev = jnp.concatenate([zero, t[:, :-1]], axis=1)
    t_next = jnp.concatenate([t[:, 1:], zero], axis=1)
    return t + mu_prev * (t_prev - t) + mu_next * (t_next - t)


def rwkv_prepare(sh, mu_prev, mu_next, k_k):
    sh = centred_shift(sh, mu_prev, mu_next)
    r, k, v, wd_f, wd_b, ad_f, ad_b = split_cols(sh, RWKV_SPLITS)
    B, L = sh.shape[:2]
    r, k, v = (t.reshape(B, L, RWKV_HEADS, RWKV_N) for t in (r, k, v))
    kk = l2_normalize(k * k_k)
    return r, k, v, kk, (wd_f, wd_b), (ad_f, ad_b)


def rwkv_direction_inputs(r, k, v, wd, ad, w0, w_up, a0, a_up, k_a, r_k):
    shape = r.shape
    z = (w0 + jnp.tanh(wd) @ w_up).astype(jnp.float32)
    w = jnp.exp(-RWKV_DECAY_SCALE * jax.nn.sigmoid(z)).reshape(shape)
    a = jax.nn.sigmoid(a0 + ad @ a_up).reshape(shape)
    k_dir = k * (1.0 + (a - 1.0) * k_a)
    bonus = jnp.sum(r * k_dir * r_k, axis=-1, keepdims=True) * v
    return w, k_dir, a, bonus


def rwkv_scan(state0, r, w, k, v, kk, a, reverse):
    xs = tuple(jnp.moveaxis(t.astype(jnp.float32), 1, 0) for t in (r, w, k, v, kk, a))

    def step(S, inp):
        r_t, w_t, k_t, v_t, kk_t, a_t = inp
        S = (S * w_t[:, :, None, :]
             - jnp.einsum('bhvk,bhk->bhv', S, kk_t)[..., None] * (kk_t * a_t)[:, :, None, :]
             + v_t[..., None] * k_t[:, :, None, :])
        return S, jnp.einsum('bhvk,bhk->bhv', S, r_t)

    S_final, ys = lax.scan(step, state0, xs, reverse=reverse)
    return jnp.moveaxis(ys, 0, 1), S_final


def rwkv_branch(sh_l, sh_c, mu, w0, w_up, a0, a_up, k_k, k_a, r_k, gn_w, gn_b, update_ctx):
    hd = (RWKV_HEADS, RWKV_N)
    k_k, k_a, r_k, gn_w, gn_b = (t.reshape(hd) for t in (k_k, k_a, r_k, gn_w, gn_b))
    lat = rwkv_prepare(sh_l, mu[0], mu[1], k_k)
    cx = rwkv_prepare(sh_c, mu[0], mu[1], k_k)
    B = sh_l.shape[0]
    ys_lat, bon_lat, ys_ctx, bon_ctx = [], [], [], []
    for d in range(2):
        reverse = d == 1
        w_c, kd_c, a_c, b_c = rwkv_direction_inputs(cx[0], cx[1], cx[2], cx[4][d], cx[5][d],
                                                    w0[d], w_up[d], a0[d], a_up[d], k_a, r_k)
        state0 = jnp.zeros((B, RWKV_HEADS, RWKV_N, RWKV_N), jnp.float32)
        y_c, state_c = rwkv_scan(state0, cx[0], w_c, kd_c, cx[2], cx[3], a_c, reverse)
        w_l, kd_l, a_l, b_l = rwkv_direction_inputs(lat[0], lat[1], lat[2], lat[4][d], lat[5][d],
                                                    w0[d], w_up[d], a0[d], a_up[d], k_a, r_k)
        y_l, _ = rwkv_scan(state_c, lat[0], w_l, kd_l, lat[2], lat[3], a_l, reverse)
        ys_lat.append(y_l)
        bon_lat.append(b_l)
        ys_ctx.append(y_c)
        bon_ctx.append(b_c)
    o_l = group_norm_heads(ys_lat[0] + ys_lat[1], gn_w, gn_b) + bon_lat[0] + bon_lat[1]
    o_c = None
    if update_ctx:
        o_c = flat_heads(group_norm_heads(ys_ctx[0] + ys_ctx[1], gn_w, gn_b) + bon_ctx[0] + bon_ctx[1])
    return flat_heads(o_l), o_c


def merge_branches(outs, gate_logits, merge_b, branch_w, out_w):
    g = jax.nn.sigmoid(gate_logits + merge_b)
    y = g[..., :D_MODEL] * (outs[0] @ branch_w[0])
    for i in range(1, N_BRANCH):
        y = y + g[..., i * D_MODEL:(i + 1) * D_MODEL] * (outs[i] @ branch_w[i])
    return y @ out_w


def hybrid_layer(x, ctx, c, c_ctx, ada_w, ada_b, in_w, mla_q_norm, mla_w_uq, mla_kv_norm, mla_w_ukv,
                 rwkv_mu, rwkv_w0, rwkv_w_up, rwkv_a0, rwkv_a_up, rwkv_k_k, rwkv_k_a, rwkv_r_k,
                 rwkv_gn_w, rwkv_gn_b, gqa_q_norm, gqa_k_norm, diff_lambda, diff_subln,
                 merge_b, branch_w, out_w, ln_g, ln_b, lambda_init, rope32, rope64, update_ctx):
    silu = jax.nn.silu
    shift_l, scale_l, gate_l = jnp.split((silu(c) @ ada_w + ada_b)[:, None, :], 3, axis=-1)
    shift_c, scale_c, gate_c = jnp.split(silu(c_ctx) @ ada_w + ada_b, 3, axis=-1)
    pl = split_cols(modulate(x, shift_l, scale_l) @ in_w, IN_SPLITS)
    pc = split_cols(modulate(ctx, shift_c, scale_c) @ in_w, IN_SPLITS)

    qa_l, ka_l, va_l = mla_project(pl[0], pl[1], pl[2], mla_q_norm, mla_w_uq, mla_kv_norm, mla_w_ukv, rope32)
    qa_c, ka_c, va_c = mla_project(pc[0], pc[1], pc[2], mla_q_norm, mla_w_uq, mla_kv_norm, mla_w_ukv, None)
    oa_l = softmax_attention(qa_l, jnp.concatenate([ka_c, ka_l], 1), jnp.concatenate([va_c, va_l], 1), MLA_SCALE)

    ob_l, ob_c = rwkv_branch(pl[4], pc[4], rwkv_mu, rwkv_w0, rwkv_w_up, rwkv_a0, rwkv_a_up,
                             rwkv_k_k, rwkv_k_a, rwkv_r_k, rwkv_gn_w, rwkv_gn_b, update_ctx)

    qc_l, kc_l, vc_l = gqa_project(pl[6], pl[7], pl[8], gqa_q_norm, gqa_k_norm, rope64)
    qc_c, kc_c, vc_c = gqa_project(pc[6], pc[7], pc[8], gqa_q_norm, gqa_k_norm, None)
    oc_l = softmax_attention(qc_l, jnp.concatenate([kc_c, kc_l], 1), jnp.concatenate([vc_c, vc_l], 1), GQA_SCALE)

    lam = (jnp.exp(jnp.sum(diff_lambda[0] * diff_lambda[1]).astype(jnp.float32))
           - jnp.exp(jnp.sum(diff_lambda[2] * diff_lambda[3]).astype(jnp.float32)) + lambda_init)
    q1_l, q2_l, k1_l, k2_l, vd_l = diff_project(pl[10], pl[11], pl[12], rope32)
    q1_c, q2_c, k1_c, k2_c, vd_c = diff_project(pc[10], pc[11], pc[12], None)
    od_l = differential_attention(q1_l, q2_l, jnp.concatenate([k1_c, k1_l], 1), jnp.concatenate([k2_c, k2_l], 1),
                                  jnp.concatenate([vd_c, vd_l], 1), lam)
    od_l = rms_norm(od_l, diff_subln, 1e-5) * (1.0 - lambda_init)

    outs_l = [flat_heads(oa_l) * silu(pl[3]), ob_l * silu(pl[5]),
              flat_heads(oc_l) * silu(pl[9]), flat_heads(od_l) * silu(pl[13])]
    x_new = post_norm(ALPHA * x + gate_l * merge_branches(outs_l, pl[14], merge_b, branch_w, out_w), ln_g, ln_b)

    ctx_new = ctx
    if update_ctx:
        oa_c = softmax_attention(qa_c, ka_c, va_c, MLA_SCALE)
        oc_c = softmax_attention(qc_c, kc_c, vc_c, GQA_SCALE)
        od_c = rms_norm(differential_attention(q1_c, q2_c, k1_c, k2_c, vd_c, lam), diff_subln, 1e-5) * (1.0 - lambda_init)
        outs_c = [flat_heads(oa_c) * silu(pc[3]), ob_c * silu(pc[5]),
                  flat_heads(oc_c) * silu(pc[9]), flat_heads(od_c) * silu(pc[13])]
        ctx_new = post_norm(ALPHA * ctx + gate_c * merge_branches(outs_c, pc[14], merge_b, branch_w, out_w), ln_g, ln_b)
    return x_new, ctx_new


def setup_inputs(seed: int = 0) -> dict:
    key = jax.random.key(seed)
    ks = iter(jax.random.split(key, 40))

    def nrm(shape, scale):
        return scale * jax.random.normal(next(ks), shape, jnp.float32)

    def gain(shape):
        return 1.0 + nrm(shape, 0.05)

    return {
        "x": nrm((BATCH, SEQ, D_MODEL), 1.0),
        "c": nrm((BATCH, D_MODEL), 1.0),
        "ctx": nrm((BATCH, CTX_LEN, D_MODEL), 1.0),
        "c_ctx": nrm((D_MODEL,), 1.0),
        "ada_w": nrm((DEPTH, D_MODEL, 3 * D_MODEL), D_MODEL ** -0.5),
        "ada_b": nrm((DEPTH, 3 * D_MODEL), 0.02),
        "in_w": nrm((DEPTH, D_MODEL, IN_W), D_MODEL ** -0.5),
        "mla_q_norm": gain((DEPTH, MLA_Q_LORA)),
        "mla_w_uq": nrm((DEPTH, MLA_Q_LORA, MLA_HEADS * (MLA_NOPE + MLA_ROPE)), MLA_Q_LORA ** -0.5),
        "mla_kv_norm": gain((DEPTH, MLA_KV_LORA)),
        "mla_w_ukv": nrm((DEPTH, MLA_KV_LORA, MLA_HEADS * (MLA_NOPE + MLA_V)), MLA_KV_LORA ** -0.5),
        "rwkv_mu": jax.random.uniform(next(ks), (DEPTH, 2, RWKV_SHIFT_W), jnp.float32, 0.0, 0.5),
        "rwkv_w0": nrm((DEPTH, 2, BRANCH_W), 0.5),
        "rwkv_w_up": nrm((DEPTH, 2, RWKV_DECAY_LORA, BRANCH_W), RWKV_DECAY_LORA ** -0.5),
        "rwkv_a0": nrm((DEPTH, 2, BRANCH_W), 0.5),
        "rwkv_a_up": nrm((DEPTH, 2, RWKV_AAA_LORA, BRANCH_W), RWKV_AAA_LORA ** -0.5),
        "rwkv_k_k": 0.85 + nrm((DEPTH, BRANCH_W), 0.05),
        "rwkv_k_a": gain((DEPTH, BRANCH_W)),
        "rwkv_r_k": nrm((DEPTH, BRANCH_W), 0.1),
        "rwkv_gn_w": gain((DEPTH, BRANCH_W)),
        "rwkv_gn_b": nrm((DEPTH, BRANCH_W), 0.02),
        "gqa_q_norm": gain((DEPTH, HEAD_DIM)),
        "gqa_k_norm": gain((DEPTH, HEAD_DIM)),
        "diff_lambda": nrm((DEPTH, 4, DIFF_D), 0.1),
        "diff_subln": gain((DEPTH, DIFF_V)),
        "merge_b": nrm((DEPTH, N_BRANCH * D_MODEL), 0.02),
        "branch_w": nrm((DEPTH, N_BRANCH, BRANCH_W, D_MODEL), BETA * BRANCH_W ** -0.5),
        "out_w": nrm((DEPTH, D_MODEL, D_MODEL), BETA * D_MODEL ** -0.5),
        "ln_g": gain((DEPTH, D_MODEL)),
        "ln_b": nrm((DEPTH, D_MODEL), 0.02),
    }


def reference(x, c, ctx, c_ctx, ada_w, ada_b, in_w, mla_q_norm, mla_w_uq, mla_kv_norm, mla_w_ukv,
              rwkv_mu, rwkv_w0, rwkv_w_up, rwkv_a0, rwkv_a_up, rwkv_k_k, rwkv_k_a, rwkv_r_k,
              rwkv_gn_w, rwkv_gn_b, gqa_q_norm, gqa_k_norm, diff_lambda, diff_subln,
              merge_b, branch_w, out_w, ln_g, ln_b):
    L = x.shape[1]
    rows = L // GRID_W
    row = jnp.repeat(jnp.arange(rows), GRID_W).astype(jnp.float32)
    col = jnp.tile(jnp.arange(GRID_W), rows).astype(jnp.float32)
    rope32 = axial_rope_tables(row, col, MLA_ROPE)
    rope64 = axial_rope_tables(row, col, HEAD_DIM)
    for l in range(DEPTH):
        x, ctx = hybrid_layer(
            x, ctx, c, c_ctx, ada_w[l], ada_b[l], in_w[l], mla_q_norm[l], mla_w_uq[l], mla_kv_norm[l], mla_w_ukv[l],
            rwkv_mu[l], rwkv_w0[l], rwkv_w_up[l], rwkv_a0[l], rwkv_a_up[l], rwkv_k_k[l], rwkv_k_a[l], rwkv_r_k[l],
            rwkv_gn_w[l], rwkv_gn_b[l], gqa_q_norm[l], gqa_k_norm[l], diff_lambda[l], diff_subln[l],
            merge_b[l], branch_w[l], out_w[l], ln_g[l], ln_b[l],
            lambda_init=0.8 - 0.6 * math.exp(-0.3 * l), rope32=rope32, rope64=rope64,
            update_ctx=l < DEPTH - 1)
    return x
```

```cpp
#include <hip/hip_runtime.h>
#include <hip/hip_cooperative_groups.h>
#include <cstdio>
namespace cg = cooperative_groups;

#ifndef REPEAT_PH
#define REPEAT_PH -1
#endif
#ifndef MULTI_LAUNCH
#define MULTI_LAUNCH 0
#endif

typedef unsigned short u16;
typedef __attribute__((ext_vector_type(8))) short bf16x8;
typedef __attribute__((ext_vector_type(4))) short s16x4;
typedef __attribute__((ext_vector_type(16))) float f32x16;
typedef __attribute__((ext_vector_type(2))) __bf16 bf16x2_t;
typedef __attribute__((ext_vector_type(2))) float f32x2;
typedef __attribute__((ext_vector_type(8))) _Float16 h8;
typedef __attribute__((ext_vector_type(8))) float f8;
typedef __attribute__((ext_vector_type(4))) unsigned u32x4;
typedef __attribute__((ext_vector_type(2))) unsigned u32x2;
typedef __attribute__((ext_vector_type(4))) float f32x4v;
#define DI __device__ __forceinline__
#define MFMA32(a, b, c) __builtin_amdgcn_mfma_f32_32x32x16_bf16((a), (b), (c), 0, 0, 0)

constexpr int NB = 8, T = 4352, DM = 1024, HB = 4, MH = HB * T, MT = NB * T;
constexpr int NPAD = 7936, NP1 = 3840;
constexpr int C_QLAT = 0, C_KVLAT = 256, C_KROPE = 384, C_GA = 512, C_SH = 768, C_GB = 1792, C_QC = 2048, C_KC = 2304,
              C_VC = 2432, C_GC = 2560, C_QD = 2816, C_KD = 3072, C_VD = 3328, C_GD = 3584, C_MG = 3840;
constexpr float LOG2E = 1.4426950408889634f;
constexpr float ALPHA_DN = 1.4142135623730951f;
constexpr int SMEM_BYTES = 73728 + 1024;
constexpr int CP = 132;

struct Params {
  const float* in[30];
  float* out;
  u16 *Wt_in, *Wt_uq, *Wt_ukv, *Wt_br, *Wt_out, *Wl;
  float *mod, *rope16, *rope8, *lam;
  unsigned* cnt;
  unsigned* bar;
  u16* A;
  float* ctx1;
  u16* P;
  u16* G;
  u16 *QA, *KA, *VAt, *QC, *KC, *VCt, *QD, *KD, *VDt;
  u16* SI;
  float* bonus;
  u16* yscan;
  u16* Gs;
  u16* o;
  u16* ybuf;
  float* hbuf;
};

DI int otid() { int t; asm volatile("v_mov_b32 %0, %1" : "=v"(t) : "v"((int)threadIdx.x)); return t; }
DI float bf2f(u16 x) { return __uint_as_float(((unsigned)x) << 16); }
DI unsigned pack2(float a, float b) {
  f32x2 v = {a, b};
  bf16x2_t r = __builtin_convertvector(v, bf16x2_t);
  return __builtin_bit_cast(unsigned, r);
}
DI u16 f2bf(float a) { return (u16)(pack2(a, 0.f) & 0xffffu); }
DI float lo_bf(unsigned w) { return __uint_as_float(w << 16); }
DI float hi_bf(unsigned w) { return __uint_as_float(w & 0xffff0000u); }
DI float sigmoidf_(float x) { return __builtin_amdgcn_rcpf(1.f + __builtin_amdgcn_exp2f(-1.4426950408889634f * x)); }
DI float siluf_(float x) { return x * __builtin_amdgcn_rcpf(1.f + __builtin_amdgcn_exp2f(-1.4426950408889634f * x)); }
DI float allreduce16(float x) {
  x += __int_as_float(__builtin_amdgcn_mov_dpp(__float_as_int(x), 0xB1, 0xf, 0xf, true));
  x += __int_as_float(__builtin_amdgcn_mov_dpp(__float_as_int(x), 0x4E, 0xf, 0xf, true));
  x += __int_as_float(__builtin_amdgcn_mov_dpp(__float_as_int(x), 0x141, 0xf, 0xf, true));
  x += __int_as_float(__builtin_amdgcn_mov_dpp(__float_as_int(x), 0x140, 0xf, 0xf, true));
  return x;
}
DI float xsum32(float x) { auto r = __builtin_amdgcn_permlane32_swap(__float_as_uint(x), __float_as_uint(x), false, false); return __uint_as_float(r[0]) + __uint_as_float(r[1]); }
DI float xmax32(float x) { auto r = __builtin_amdgcn_permlane32_swap(__float_as_uint(x), __float_as_uint(x), false, false); return fmaxf(__uint_as_float(r[0]), __uint_as_float(r[1])); }
DI float xsum16(float x) { auto r = __builtin_amdgcn_permlane16_swap(__float_as_uint(x), __float_as_uint(x), false, false); return __uint_as_float(r[0]) + __uint_as_float(r[1]); }
DI float wave_sum(float v) { return xsum32(xsum16(allreduce16(v))); }
DI void unpack8(const u32x4& u, float* v) {
  v[0] = lo_bf(u.x); v[1] = hi_bf(u.x); v[2] = lo_bf(u.y); v[3] = hi_bf(u.y);
  v[4] = lo_bf(u.z); v[5] = hi_bf(u.z); v[6] = lo_bf(u.w); v[7] = hi_bf(u.w);
}
DI u32x4 pack8(const float* v) {
  u32x4 u;
  u.x = pack2(v[0], v[1]); u.y = pack2(v[2], v[3]); u.z = pack2(v[4], v[5]); u.w = pack2(v[6], v[7]);
  return u;
}
DI const float* xrow(const Params& p, int l, int b, int t) {
  if (l == 0) return t < 256 ? p.in[2] + ((long)b * 256 + t) * DM : p.in[0] + ((long)b * 4096 + (t - 256)) * DM;
  return t < 256 ? p.ctx1 + ((long)b * 256 + t) * DM : p.out + ((long)b * 4096 + (t - 256)) * DM;
}

template <int NI>
DI void gemm_core(f32x16 (&acc)[2][NI], const u16* __restrict__ A, int lda, const u16* __restrict__ W, int ldw, int K,
                  u16* sA0, u16* sW0) {
  constexpr int GBUF = 2 * 128 * 72;
  const int tid = otid(), lane = tid & 63, wv = tid >> 6, wm = wv >> 1, wn = wv & 1;
  const int r = lane & 31, h = lane >> 5;
  const int lc = tid & 7, lr = tid >> 3;
  const unsigned aoff = (unsigned)(lr * lda + lc * 8);
  const unsigned woff = (unsigned)(lr * ldw + lc * 8);
  u32x4 raA[4], rwA[2 * NI], raB[4], rwB[2 * NI];
#define G_LOAD(RA, RW, kt_) { _Pragma("unroll") for (int i = 0; i < 4; i++) { \
      RA[i] = *(const u32x4*)(A + (aoff + (unsigned)(i * 32 * lda) + (unsigned)((kt_) * 64))); \
      if (i < 2 * NI) RW[i] = *(const u32x4*)(W + (woff + (unsigned)(i * 32 * ldw) + (unsigned)((kt_) * 64))); } }
#define G_STORE(RA, RW, buf_) { u16* dA = sA0 + (buf_) * GBUF; u16* dW = sW0 + (buf_) * GBUF; _Pragma("unroll") for (int i = 0; i < 4; i++) { \
      *(u32x4*)(dA + (lr + i * 32) * 72 + lc * 8) = RA[i]; \
      if (i < 2 * NI) *(u32x4*)(dW + (lr + i * 32) * 72 + lc * 8) = RW[i]; } }
#define G_COMPUTE(buf_) { const u16* sA = sA0 + (buf_) * GBUF; const u16* sW = sW0 + (buf_) * GBUF; _Pragma("unroll") for (int ks = 0; ks < 4; ks++) { \
      bf16x8 af[2], bfv[NI]; \
      _Pragma("unroll") for (int mi = 0; mi < 2; mi++) af[mi] = *(const bf16x8*)(sA + (wm * 64 + mi * 32 + r) * 72 + ks * 16 + h * 8); \
      _Pragma("unroll") for (int ni = 0; ni < NI; ni++) bfv[ni] = *(const bf16x8*)(sW + (wn * 32 * NI + ni * 32 + r) * 72 + ks * 16 + h * 8); \
      _Pragma("unroll") for (int mi = 0; mi < 2; mi++) _Pragma("unroll") for (int ni = 0; ni < NI; ni++) acc[mi][ni] = MFMA32(af[mi], bfv[ni], acc[mi][ni]); } }
  const int nk = K >> 6;
  G_LOAD(raA, rwA, 0)
  G_STORE(raA, rwA, 0)
  G_LOAD(raA, rwA, 1)
  if (nk > 2) G_LOAD(raB, rwB, 2)
  __syncthreads();
  for (int kt = 0; kt < nk; kt += 2) {
    G_STORE(raA, rwA, 1)
    if (kt + 3 < nk) G_LOAD(raA, rwA, kt + 3)
    G_COMPUTE(0)
    __syncthreads();
    if (kt + 2 < nk) G_STORE(raB, rwB, 0)
    if (kt + 4 < nk) G_LOAD(raB, rwB, kt + 4)
    G_COMPUTE(1)
    __syncthreads();
  }
#undef G_LOAD
#undef G_STORE
#undef G_COMPUTE
}
template <int NI>
DI void zero_acc(f32x16 (&acc)[2][NI]) {
#pragma unroll
  for (int a = 0; a < 2; a++)
#pragma unroll
    for (int b = 0; b < NI; b++)
#pragma unroll
      for (int i = 0; i < 16; i++) acc[a][b][i] = 0.f;
}
template <int NI>
DI void dump_acc(const f32x16 (&acc)[2][NI], float* sC) {
  const int tid = otid(), lane = tid & 63, wv = tid >> 6, wm = wv >> 1, wn = wv & 1;
  const int r = lane & 31, h = lane >> 5;
#pragma unroll
  for (int mi = 0; mi < 2; mi++)
#pragma unroll
    for (int ni = 0; ni < NI; ni++)
#pragma unroll
      for (int i = 0; i < 16; i++) {
        int row = wm * 64 + mi * 32 + (i & 3) + 8 * (i >> 2) + 4 * h;
        int col = wn * 32 * NI + ni * 32 + r;
        sC[row * CP + col] = acc[mi][ni][i];
      }
}


DI void gemm_core256(f32x16 (&acc)[4][2], const u16* __restrict__ A, int lda, const u16* __restrict__ W, int ldw, int K,
                     u16* sA, u16* sW) {
  const int tid = otid(), lane = tid & 63, wv = tid >> 6, wm = wv >> 1, wn = wv & 1;
  const int r = lane & 31, h = lane >> 5;
  const int lc = tid & 7, lr = tid >> 3;
  const unsigned aoff = (unsigned)(lr * lda + lc * 8);
  const unsigned woff = (unsigned)(lr * ldw + lc * 8);
  u32x4 ra[8], rw[4];
#pragma unroll
  for (int i = 0; i < 8; i++) {
    ra[i] = *(const u32x4*)(A + (aoff + (unsigned)(i * 32 * lda)));
    if (i < 4) rw[i] = *(const u32x4*)(W + (woff + (unsigned)(i * 32 * ldw)));
  }
  const int nk = K >> 6;
  for (int kt = 0; kt < nk; kt++) {
#pragma unroll
    for (int i = 0; i < 8; i++) {
      *(u32x4*)(sA + (lr + i * 32) * 72 + lc * 8) = ra[i];
      if (i < 4) *(u32x4*)(sW + (lr + i * 32) * 72 + lc * 8) = rw[i];
    }
    __syncthreads();
    if (kt + 1 < nk) {
#pragma unroll
      for (int i = 0; i < 8; i++) {
        ra[i] = *(const u32x4*)(A + (aoff + (unsigned)(i * 32 * lda) + (unsigned)((kt + 1) * 64)));
        if (i < 4) rw[i] = *(const u32x4*)(W + (woff + (unsigned)(i * 32 * ldw) + (unsigned)((kt + 1) * 64)));
      }
    }
#pragma unroll
    for (int ks = 0; ks < 4; ks++) {
      bf16x8 af[4], bfv[2];
#pragma unroll
      for (int mi = 0; mi < 4; mi++) af[mi] = *(const bf16x8*)(sA + (wm * 128 + mi * 32 + r) * 72 + ks * 16 + h * 8);
#pragma unroll
      for (int ni = 0; ni < 2; ni++) bfv[ni] = *(const bf16x8*)(sW + (wn * 64 + ni * 32 + r) * 72 + ks * 16 + h * 8);
#pragma unroll
      for (int mi = 0; mi < 4; mi++)
#pragma unroll
        for (int ni = 0; ni < 2; ni++) acc[mi][ni] = MFMA32(af[mi], bfv[ni], acc[mi][ni]);
    }
    __syncthreads();
  }
}
DI void dump_acc256(const f32x16 (&acc)[4][2], float* sC, int hf) {
  const int tid = otid(), lane = tid & 63, wv = tid >> 6, wm = wv >> 1, wn = wv & 1;
  const int r = lane & 31, h = lane >> 5;
  if (wm == hf) {
#pragma unroll
    for (int mi = 0; mi < 4; mi++)
#pragma unroll
      for (int ni = 0; ni < 2; ni++)
#pragma unroll
        for (int i = 0; i < 16; i++) {
          int row = mi * 32 + (i & 3) + 8 * (i >> 2) + 4 * h;
          int col = wn * 64 + ni * 32 + r;
          sC[row * CP + col] = acc[mi][ni][i];
        }
  }
}
template <int MODE>
DI int colmap(int n) {
  if (MODE == 0) return n < 416 ? n : (n < 512 ? -1 : n - 96);
  if (MODE == 1) return n < 256 ? (n >> 6) * 96 + (n & 63) : ((n - 256) >> 5) * 96 + 64 + ((n - 256) & 31);
  if (MODE == 2) return n < 256 ? (n >> 6) * 128 + (n & 63) : ((n - 256) >> 6) * 128 + 64 + ((n - 256) & 63);
  return n;
}
template <int MODE>
DI void conv_weight(u16* dst, const float* src, int Np, int K, int ld, const float* rowscale, long gtid, long gsz) {
  long total = (long)Np * (K / 8);
  for (long j = gtid; j < total; j += gsz) {
    int n = (int)(j % Np), kc = (int)(j / Np);
    int c = colmap<MODE>(n);
    float v[8];
#pragma unroll
    for (int q = 0; q < 8; q++) {
      int k = kc * 8 + q;
      float x = (c >= 0) ? src[(long)k * ld + c] : 0.f;
      if (rowscale) x *= rowscale[k];
      v[q] = x;
    }
    *(u32x4*)(dst + (long)n * K + kc * 8) = pack8(v);
  }
}

DI void phase_prologue(const Params& p, char* smem) {
  const long gsz = (long)gridDim.x * blockDim.x, gtid = (long)blockIdx.x * blockDim.x + otid();
  for (int l = 0; l < 2; l++) {
    conv_weight<0>(p.Wt_in + (long)l * NPAD * 1024, p.in[6] + (long)l * 1024 * 7840, NPAD, 1024, 7840, nullptr, gtid, gsz);
    conv_weight<1>(p.Wt_uq + (long)l * 384 * 256, p.in[8] + (long)l * 256 * 384, 384, 256, 384, p.in[7] + l * 256, gtid, gsz);
    conv_weight<2>(p.Wt_ukv + (long)l * 512 * 128, p.in[10] + (long)l * 128 * 512, 512, 128, 512, p.in[9] + l * 128, gtid, gsz);
    for (int i = 0; i < 4; i++)
      conv_weight<3>(p.Wt_br + ((long)l * 4 + i) * 1024 * 256, p.in[26] + ((long)l * 4 + i) * 256 * 1024, 1024, 256, 1024, nullptr, gtid, gsz);
    conv_weight<3>(p.Wt_out + (long)l * 1024 * 1024, p.in[27] + (long)l * 1024 * 1024, 1024, 1024, 1024, nullptr, gtid, gsz);
    for (int d = 0; d < 2; d++) {
      conv_weight<3>(p.Wl + ((long)l * 4 + d) * 256 * 64, p.in[13] + ((long)l * 2 + d) * 64 * 256, 256, 64, 256, nullptr, gtid, gsz);
      conv_weight<3>(p.Wl + ((long)l * 4 + 2 + d) * 256 * 64, p.in[15] + ((long)l * 2 + d) * 64 * 256, 256, 64, 256, nullptr, gtid, gsz);
    }
  }
  if (blockIdx.x == 0) {
    int tid = otid();
    for (int e = tid; e < 64 * 16; e += 256) {
      int pos = e >> 4, j = e & 15;
      float inv = exp2f(-(float)j * (13.287712379549449f / 16.f));
      float rev = (float)pos * inv * 0.15915494309189535f;
      rev = rev - floorf(rev);
      p.rope16[2 * e] = __builtin_amdgcn_cosf(rev);
      p.rope16[2 * e + 1] = __builtin_amdgcn_sinf(rev);
    }
    for (int e = tid; e < 64 * 8; e += 256) {
      int pos = e >> 3, j = e & 7;
      float inv = exp2f(-(float)j * (13.287712379549449f / 8.f));
      float rev = (float)pos * inv * 0.15915494309189535f;
      rev = rev - floorf(rev);
      p.rope8[2 * e] = __builtin_amdgcn_cosf(rev);
      p.rope8[2 * e + 1] = __builtin_amdgcn_sinf(rev);
    }
    if (tid < 2) {
      const float* dl = p.in[23] + tid * 128;
      float s1 = 0.f, s2 = 0.f;
      for (int i = 0; i < 32; i++) { s1 += dl[i] * dl[32 + i]; s2 += dl[64 + i] * dl[96 + i]; }
      float li = 0.8f - 0.6f * expf(-0.3f * (float)tid);
      p.lam[tid] = expf(s1) - expf(s2) + li;
      p.lam[2 + tid] = li;
    }
  }
  float* sc = (float*)smem;
  float* sp = sc + 9 * 1024;
  for (int it = blockIdx.x; it < 192; it += gridDim.x) {
    int l = it / 96, nb = it % 96;
    int tid = otid();
    __syncthreads();
    for (int e = tid; e < 9 * 1024; e += 256) {
      int j = e >> 10, k = e & 1023;
      float cv = j < 8 ? p.in[1][j * 1024 + k] : p.in[3][k];
      sc[e] = siluf_(cv);
    }
    __syncthreads();
    int col = tid & 31, kq = tid >> 5;
    int n = nb * 32 + col;
    const float* w = p.in[4] + (long)l * 1024 * 3072 + n;
    float acc[9];
#pragma unroll
    for (int j = 0; j < 9; j++) acc[j] = 0.f;
    for (int k0 = kq * 128; k0 < kq * 128 + 128; k0 += 16) {
      float wv[16];
#pragma unroll
      for (int q = 0; q < 16; q++) wv[q] = w[(long)(k0 + q) * 3072];
#pragma unroll
      for (int q = 0; q < 16; q++)
#pragma unroll
        for (int j = 0; j < 9; j++) acc[j] += sc[j * 1024 + k0 + q] * wv[q];
    }
#pragma unroll
    for (int j = 0; j < 9; j++) sp[(kq * 9 + j) * 32 + col] = acc[j];
    __syncthreads();
    for (int e = tid; e < 9 * 32; e += 256) {
      int j = e >> 5, c2 = e & 31;
      float sacc = 0.f;
#pragma unroll
      for (int q = 0; q < 8; q++) sacc += sp[(q * 9 + j) * 32 + c2];
      int n2 = nb * 32 + c2;
      p.mod[((long)l * 9 + j) * 3072 + n2] = sacc + p.in[5][l * 3072 + n2];
    }
  }
}

DI void phase_rows(const Params& p, int mode, int half) {
  const int tid_ = otid(); const int lane = tid_ & 63, wv = tid_ >> 6;
  const int nrows = (mode == 0) ? MT : MH;
  const int gw = blockIdx.x * 4 + wv, nw = gridDim.x * 4;
  for (int rr = gw; rr < nrows; rr += nw) {
    int m = (mode == 0) ? rr : half * MH + rr;
    int b = m / T, t = m % T;
    if (mode == 2 && t < 256) continue;
    const float* src = (mode == 0) ? xrow(p, 0, b, t) : p.hbuf + (long)rr * DM;
    float v[16];
#pragma unroll
    for (int q = 0; q < 4; q++) {
      f32x4v x4 = *(const f32x4v*)(src + q * 256 + lane * 4);
      v[q * 4] = x4.x; v[q * 4 + 1] = x4.y; v[q * 4 + 2] = x4.z; v[q * 4 + 3] = x4.w;
    }
    if (mode >= 1) {
      int l = mode - 1;
      float s = 0.f;
#pragma unroll
      for (int i = 0; i < 16; i++) s += v[i];
      float mu = wave_sum(s) * (1.f / 1024.f);
      float s2 = 0.f;
#pragma unroll
      for (int i = 0; i < 16; i++) { float d = v[i] - mu; s2 += d * d; }
      float rs = rsqrtf(wave_sum(s2) * (1.f / 1024.f) + 1e-5f);
      const float* g = p.in[28] + l * 1024;
      const float* bb = p.in[29] + l * 1024;
      float* dst = (mode == 2) ? p.out + ((long)b * 4096 + (t - 256)) * DM
                               : (t < 256 ? p.ctx1 + ((long)b * 256 + t) * DM : p.out + ((long)b * 4096 + (t - 256)) * DM);
#pragma unroll
      for (int q = 0; q < 4; q++) {
        int c = q * 256 + lane * 4;
        f32x4v g4 = *(const f32x4v*)(g + c), b4 = *(const f32x4v*)(bb + c);
        v[q * 4] = (v[q * 4] - mu) * rs * g4.x + b4.x;
        v[q * 4 + 1] = (v[q * 4 + 1] - mu) * rs * g4.y + b4.y;
        v[q * 4 + 2] = (v[q * 4 + 2] - mu) * rs * g4.z + b4.z;
        v[q * 4 + 3] = (v[q * 4 + 3] - mu) * rs * g4.w + b4.w;
        *(f32x4v*)(dst + c) = f32x4v{v[q * 4], v[q * 4 + 1], v[q * 4 + 2], v[q * 4 + 3]};
      }
    }
    if (mode <= 1) {
      int l = mode;
      float s = 0.f;
#pragma unroll
      for (int i = 0; i < 16; i++) s += v[i];
      float mu = wave_sum(s) * (1.f / 1024.f);
      float s2 = 0.f;
#pragma unroll
      for (int i = 0; i < 16; i++) { float d = v[i] - mu; s2 += d * d; }
      float rs = rsqrtf(wave_sum(s2) * (1.f / 1024.f) + 1e-6f);
      const float* md = p.mod + ((long)l * 9 + (t < 256 ? 8 : b)) * 3072;
      u16* dst = p.A + (long)m * DM;
#pragma unroll
      for (int q = 0; q < 4; q++) {
        int c = q * 256 + lane * 4;
        f32x4v sh4 = *(const f32x4v*)(md + c), sc4 = *(const f32x4v*)(md + 1024 + c);
        float a0 = (v[q * 4] - mu) * rs * (1.f + sc4.x) + sh4.x;
        float a1 = (v[q * 4 + 1] - mu) * rs * (1.f + sc4.y) + sh4.y;
        float a2 = (v[q * 4 + 2] - mu) * rs * (1.f + sc4.z) + sh4.z;
        float a3 = (v[q * 4 + 3] - mu) * rs * (1.f + sc4.w) + sh4.w;
        u32x2 o2; o2.x = pack2(a0, a1); o2.y = pack2(a2, a3);
        *(u32x2*)(dst + c) = o2;
      }
    }
  }
}

DI void phase_inproj(const Params& p, int l, int half, char* smem) {
  u16* sA = (u16*)smem; u16* sW = sA + 256 * 72; float* sC = (float*)smem;
  const int tid = otid();
  const int ntiles = 68 * 30;
  for (int it = blockIdx.x; it < ntiles; it += gridDim.x) {
    int tm = it / 30, tn = it % 30;
    f32x16 acc[4][2];
#pragma unroll
    for (int a = 0; a < 4; a++)
#pragma unroll
      for (int b = 0; b < 2; b++)
#pragma unroll
        for (int i = 0; i < 16; i++) acc[a][b][i] = 0.f;
    gemm_core256(acc, p.A + ((long)half * MH + tm * 256) * DM, DM, p.Wt_in + ((long)l * NPAD + tn * 128) * 1024, 1024, 1024, sA, sW);
#pragma unroll
    for (int hf = 0; hf < 2; hf++) {
      dump_acc256(acc, sC, hf);
      __syncthreads();
#pragma unroll
      for (int ps = 0; ps < 8; ps++) {
        int row = (tid >> 4) + 16 * ps, ch = tid & 15;
        const float* s = sC + row * CP + ch * 8;
        float v[8];
        f32x4v a = *(const f32x4v*)s, b = *(const f32x4v*)(s + 4);
        v[0] = a.x; v[1] = a.y; v[2] = a.z; v[3] = a.w; v[4] = b.x; v[5] = b.y; v[6] = b.z; v[7] = b.w;
        {
          int gsel = (tn == 4 || tn == 5) ? 0 : (tn == 14 || tn == 15) ? 1 : (tn == 20 || tn == 21) ? 2 : (tn == 28 || tn == 29) ? 3 : -1;
          if (gsel >= 0) *(u32x4*)(p.Gs + ((long)tm * 256 + hf * 128 + row) * 1024 + gsel * 256 + (tn & 1) * 128 + ch * 8) = pack8(v);
          else *(u32x4*)(p.P + ((long)tm * 256 + hf * 128 + row) * NP1 + tn * 128 + ch * 8) = pack8(v);
        }
      }
      __syncthreads();
    }
  }
}

DI void load64(const u16* src, float* v) {
#pragma unroll
  for (int q = 0; q < 8; q++) { u32x4 u = *(const u32x4*)(src + q * 8); unpack8(u, v + q * 8); }
}
DI void store64(u16* dst, const float* v) {
#pragma unroll
  for (int q = 0; q < 8; q++) *(u32x4*)(dst + q * 8) = pack8(v + q * 8);
}
DI void rope64(float* v, const float* T16, int row, int col) {
#pragma unroll
  for (int i = 0; i < 32; i++) {
    f32x2 cs = (i < 16) ? *(const f32x2*)(T16 + (row * 16 + i) * 2) : *(const f32x2*)(T16 + (col * 16 + (i - 16)) * 2);
    float t1 = v[i], t2 = v[i + 32];
    v[i] = t1 * cs.x - t2 * cs.y;
    v[i + 32] = t2 * cs.x + t1 * cs.y;
  }
}
DI void rope32(float* v, const float* T8, int row, int col) {
#pragma unroll
  for (int i = 0; i < 16; i++) {
    f32x2 cs = (i < 8) ? *(const f32x2*)(T8 + (row * 8 + i) * 2) : *(const f32x2*)(T8 + (col * 8 + (i - 8)) * 2);
    float t1 = v[i], t2 = v[i + 16];
    v[i] = t1 * cs.x - t2 * cs.y;
    v[i + 16] = t2 * cs.x + t1 * cs.y;
  }
}
DI void attn_prep_block(const Params& p, int l, int blk) {
  const int j = blk * 256 + otid();
  const int u = j / MH, mh = j % MH;
  const int bb = mh / T, t = mh % T;
  const bool lat = t >= 256;
  const int tl = t - 256, row = tl >> 6, col = tl & 63;
  const u16* prow = p.P + (long)mh * NP1;
  float v[64];
  if (u < 4) {
    load64(prow + C_QC + u * 64, v);
    float ss = 0.f;
#pragma unroll
    for (int i = 0; i < 64; i++) ss += v[i] * v[i];
    float rs = rsqrtf(ss * (1.f / 64.f) + 1e-6f);
    const float* g = p.in[21] + l * 64;
#pragma unroll
    for (int i = 0; i < 64; i++) v[i] = v[i] * rs * g[i];
    if (lat) rope64(v, p.rope16, row, col);
    const float sc = 0.125f * LOG2E;
#pragma unroll
    for (int i = 0; i < 64; i++) v[i] *= sc;
    store64(p.QC + ((long)(bb * 4 + u) * T + t) * 64, v);
  } else if (u < 6) {
    int hk = u - 4;
    load64(prow + C_KC + hk * 64, v);
    float ss = 0.f;
#pragma unroll
    for (int i = 0; i < 64; i++) ss += v[i] * v[i];
    float rs = rsqrtf(ss * (1.f / 64.f) + 1e-6f);
    const float* g = p.in[22] + l * 64;
#pragma unroll
    for (int i = 0; i < 64; i++) v[i] = v[i] * rs * g[i];
    if (lat) rope64(v, p.rope16, row, col);
    store64(p.KC + ((long)(bb * 2 + hk) * T + t) * 64, v);
  } else if (u < 8) {
    int hk = u - 6;
    const u16* s = prow + C_VC + hk * 64;
    u16* d = p.VCt + (long)(bb * 2 + hk) * 64 * T + t;
#pragma unroll
    for (int q = 0; q < 8; q++) {
      u32x4 w = *(const u32x4*)(s + q * 8);
      unsigned ww[4] = {w.x, w.y, w.z, w.w};
#pragma unroll
      for (int e = 0; e < 4; e++) {
        d[(long)(q * 8 + e * 2) * T] = (u16)(ww[e] & 0xffffu);
        d[(long)(q * 8 + e * 2 + 1) * T] = (u16)(ww[e] >> 16);
      }
    }
  } else if (u < 16) {
    bool isq = u < 12;
    int hd = isq ? u - 8 : u - 12;
    load64(prow + (isq ? C_QD : C_KD) + hd * 64, v);
    if (lat) { rope32(v, p.rope8, row, col); rope32(v + 32, p.rope8, row, col); }
    if (isq) {
      const float sc = 0.17677669529663687f * LOG2E;
#pragma unroll
      for (int i = 0; i < 64; i++) v[i] *= sc;
    }
    store64((isq ? p.QD : p.KD) + ((long)(bb * 4 + hd) * T + t) * 64, v);
  } else if (u < 20) {
    int hd = u - 16;
    const u16* s = prow + C_VD + hd * 64;
    u16* d = p.VDt + (long)(bb * 4 + hd) * 64 * T + t;
#pragma unroll
    for (int q = 0; q < 8; q++) {
      u32x4 w = *(const u32x4*)(s + q * 8);
      unsigned ww[4] = {w.x, w.y, w.z, w.w};
#pragma unroll
      for (int e = 0; e < 4; e++) {
        d[(long)(q * 8 + e * 2) * T] = (u16)(ww[e] & 0xffffu);
        d[(long)(q * 8 + e * 2 + 1) * T] = (u16)(ww[e] >> 16);
      }
    }
  } else {
#pragma unroll
    for (int q = 0; q < 4; q++) { u32x4 w = *(const u32x4*)(prow + C_KROPE + q * 8); unpack8(w, v + q * 8); }
    if (lat) rope32(v, p.rope8, row, col);
    u32x4 o4[4];
#pragma unroll
    for (int q = 0; q < 4; q++) o4[q] = pack8(v + q * 8);
#pragma unroll
    for (int hh = 0; hh < 4; hh++) {
      u16* d = p.KA + ((long)(bb * 4 + hh) * T + t) * 96 + 64;
#pragma unroll
      for (int q = 0; q < 4; q++) *(u32x4*)(d + q * 8) = o4[q];
    }
  }
}

DI void mla_up_tile(const Params& p, int l, int tm, int tn, char* smem) {
  u16* sA = (u16*)smem; u16* sW = sA + 128 * 72; float* sC = (float*)smem;
  float* sRs = (float*)(smem + 73728);
  const int tid = otid();
  const bool isq = tn < 3;
  const u16* Pt = p.P + (long)tm * 128 * NP1;
  {
    int row = tid >> 1, part = tid & 1;
    int n = isq ? 128 : 64;
    const u16* s = Pt + (long)row * NP1 + (isq ? C_QLAT : C_KVLAT) + part * n;
    float ss = 0.f;
    for (int q = 0; q < n / 8; q++) {
      u32x4 w = *(const u32x4*)(s + q * 8);
      float v[8]; unpack8(w, v);
#pragma unroll
      for (int e = 0; e < 8; e++) ss += v[e] * v[e];
    }
    ss += __int_as_float(__builtin_amdgcn_mov_dpp(__float_as_int(ss), 0xB1, 0xf, 0xf, true));
    if (part == 0) sRs[row] = rsqrtf(ss * (isq ? 1.f / 256.f : 1.f / 128.f) + 1e-6f);
  }
  f32x16 acc[2][2];
  zero_acc<2>(acc);
  if (isq) gemm_core<2>(acc, Pt + C_QLAT, NP1, p.Wt_uq + ((long)l * 384 + tn * 128) * 256, 256, 256, sA, sW);
  else     gemm_core<2>(acc, Pt + C_KVLAT, NP1, p.Wt_ukv + ((long)l * 512 + (tn - 3) * 128) * 128, 128, 128, sA, sW);
  dump_acc<2>(acc, sC);
  __syncthreads();
  const int bb = (tm * 128) / T, t0 = (tm * 128) % T;
  if (isq || tn < 5) {
    const float qs = 0.10206207261596577f * LOG2E;
#pragma unroll
    for (int ps = 0; ps < 8; ps++) {
      int row = (tid >> 4) + 16 * ps, ch = tid & 15, c0 = ch * 8;
      int t = t0 + row;
      float rs = sRs[row];
      const float* s = sC + row * CP;
      float v[8];
      if (isq && tn == 2) {
        int hh = c0 >> 5, i0 = c0 & 31;
        bool lat = t >= 256;
        int tl = t - 256, rw = tl >> 6, cl = tl & 63;
#pragma unroll
        for (int e = 0; e < 8; e++) {
          int i = i0 + e;
          float x = s[c0 + e];
          if (lat) {
            int ii = i & 15;
            f32x2 cs = (ii < 8) ? *(const f32x2*)(p.rope8 + (rw * 8 + ii) * 2) : *(const f32x2*)(p.rope8 + (cl * 8 + (ii - 8)) * 2);
            if (i < 16) { float t2 = s[c0 + e + 16]; x = x * cs.x - t2 * cs.y; }
            else        { float t1 = s[c0 + e - 16]; x = x * cs.x + t1 * cs.y; }
          }
          v[e] = x * rs * qs;
        }
        *(u32x4*)(p.QA + ((long)(bb * 4 + hh) * T + t) * 96 + 64 + i0) = pack8(v);
      } else {
        int f = (isq ? tn : tn - 3) * 128 + c0;
        int hh = f >> 6, d = f & 63;
        float scl = isq ? rs * qs : rs;
#pragma unroll
        for (int e = 0; e < 8; e++) v[e] = s[c0 + e] * scl;
        *(u32x4*)((isq ? p.QA : p.KA) + ((long)(bb * 4 + hh) * T + t) * 96 + d) = pack8(v);
      }
    }
  } else {
    int row = tid & 127, fh = tid >> 7;
    int t = t0 + row;
    float rs = sRs[row];
    int hh = (tn - 5) * 2 + fh;
    u16* d = p.VAt + (long)(bb * 4 + hh) * 64 * T + t;
    const float* s = sC + row * CP + fh * 64;
#pragma unroll 8
    for (int e = 0; e < 64; e++) d[(long)e * T] = f2bf(s[e] * rs);
  }
  __syncthreads();
}

DI void rwkv_prep_group(const Params& p, int l, int grp, char* smem) {
  u16* raw = (u16*)smem;
  float* lora = (float*)(smem + 10 * 1024 * 2);
  const int tid = otid();
  const int mh0 = grp * 8, bb = mh0 / T, t0 = mh0 % T;
  const int lo = t0 < 256 ? 0 : 256, hi = t0 < 256 ? 256 : T;
  __syncthreads();
#pragma unroll
  for (int i = 0; i < 5; i++) {
    int c = tid + i * 256;
    int rr = c >> 7, ch = c & 127;
    int t = t0 - 1 + rr;
    u32x4 w = u32x4{0, 0, 0, 0};
    if (t >= lo && t < hi) w = *(const u32x4*)(p.P + ((long)bb * T + t) * NP1 + C_SH + ch * 8);
    *(u32x4*)(raw + rr * 1024 + ch * 8) = w;
  }
  __syncthreads();
  const float* mup = p.in[11] + (long)l * 2 * 1024;
  const float* mun = mup + 1024;
  const float mp0 = mup[tid], mn0 = mun[tid], mp1 = mup[256 + tid], mn1 = mun[256 + tid];
  const float mp2 = mup[512 + tid], mn2 = mun[512 + tid], mp3 = mup[768 + tid], mn3 = mun[768 + tid];
#define SHIFTED(tt, c, MP, MN) ({ float x_ = bf2f(raw[((tt) + 1) * 1024 + (c)]); float xp_ = bf2f(raw[(tt) * 1024 + (c)]); \
                          float xn_ = bf2f(raw[((tt) + 2) * 1024 + (c)]); x_ + (MP) * (xp_ - x_) + (MN) * (xn_ - x_); })
  u16* Abf = (u16*)lora;
  float* zacc = (float*)(smem + 10 * 1024 * 2 + 32 * 264 * 2);
  {
    int c = 768 + tid;
#pragma unroll
    for (int tt = 0; tt < 8; tt++) {
      float s = SHIFTED(tt, c, mp3, mn3);
      if (tid < 128) s = tanhf(s);
      Abf[tt * 264 + tid] = f2bf(s);
    }
  }
  __syncthreads();
  {
    const int lane = tid & 63, wv = tid >> 6, r = lane & 31, h = lane >> 5;
    const u16* Wb = p.Wl + (long)l * 4 * 256 * 64;
#pragma unroll
    for (int m = 0; m < 4; m++) {
      f32x16 za[2];
#pragma unroll
      for (int ni = 0; ni < 2; ni++)
#pragma unroll
        for (int i = 0; i < 16; i++) za[ni][i] = 0.f;
#pragma unroll
      for (int ks = 0; ks < 4; ks++) {
        bf16x8 af_ = *(const bf16x8*)(Abf + r * 264 + m * 64 + ks * 16 + h * 8);
#pragma unroll
        for (int ni = 0; ni < 2; ni++) {
          bf16x8 bf_ = *(const bf16x8*)(Wb + ((long)m * 256 + wv * 64 + ni * 32 + r) * 64 + ks * 16 + h * 8);
          za[ni] = MFMA32(af_, bf_, za[ni]);
        }
      }
#pragma unroll
      for (int ni = 0; ni < 2; ni++)
#pragma unroll
        for (int i = 0; i < 4; i++) zacc[(m * 8 + i + 4 * h) * 256 + wv * 64 + ni * 32 + r] = za[ni][i];
    }
  }
  __syncthreads();
  const int c = tid;
  float zf[8], zb[8], af[8], ab[8];
#pragma unroll
  for (int tt = 0; tt < 8; tt++) {
    zf[tt] = zacc[(0 * 8 + tt) * 256 + c]; zb[tt] = zacc[(1 * 8 + tt) * 256 + c];
    af[tt] = zacc[(2 * 8 + tt) * 256 + c]; ab[tt] = zacc[(3 * 8 + tt) * 256 + c];
  }
  const float w0f = p.in[12][(l * 2 + 0) * 256 + c], w0b = p.in[12][(l * 2 + 1) * 256 + c];
  const float a0f = p.in[14][(l * 2 + 0) * 256 + c], a0b = p.in[14][(l * 2 + 1) * 256 + c];
  const float kkw = p.in[16][l * 256 + c], kaw = p.in[17][l * 256 + c], rkw = p.in[18][l * 256 + c];
  const int hd = c >> 6, cc = c & 63;
#pragma unroll
  for (int tt = 0; tt < 8; tt++) {
    int t = t0 + tt;
    float r = SHIFTED(tt, c, mp0, mn0), k = SHIFTED(tt, 256 + c, mp1, mn1), v = SHIFTED(tt, 512 + c, mp2, mn2);
    float wfv = __expf(-0.6065306597126334f * sigmoidf_(w0f + zf[tt]));
    float wbv = __expf(-0.6065306597126334f * sigmoidf_(w0b + zb[tt]));
    float afv = sigmoidf_(a0f + af[tt]), abv = sigmoidf_(a0b + ab[tt]);
    float kq = k * kkw;
    float ss = wave_sum(kq * kq);
    float kk = kq * rsqrtf(ss + 1e-12f);
    float kdf = k * (1.f + (afv - 1.f) * kaw), kdb = k * (1.f + (abv - 1.f) * kaw);
    float bs = wave_sum(r * (kdf + kdb) * rkw);
    u16* si = p.SI + (((long)(bb * 4 + hd) * T + t) * 9) * 64 + cc;
    _Float16 hv;
#define PUTH(idx, val) hv = (_Float16)(val); si[(idx) * 64] = __builtin_bit_cast(u16, hv);
    PUTH(0, r) PUTH(1, kk) PUTH(2, v) PUTH(3, wfv) PUTH(4, kdf) PUTH(5, kk * afv) PUTH(6, wbv) PUTH(7, kdb) PUTH(8, kk * abv)
#undef PUTH
    p.bonus[((long)bb * T + t) * 256 + c] = bs * v;
  }
#undef SHIFTED
  __syncthreads();
}

DI void phase_prep(const Params& p, int l, int half, char* smem) {
  const int n_rw = MH / 8, n_mla = 136 * 7, n_ap = 21 * (MH / 256);
  const int total = n_rw + n_mla + n_ap;
  for (int it = blockIdx.x; it < total; it += gridDim.x) {
    if (it < n_rw) rwkv_prep_group(p, l, it, smem);
    else if (it < n_rw + n_mla) { int q = it - n_rw; mla_up_tile(p, l, q / 7, q % 7, smem); }
    else attn_prep_block(p, l, it - n_rw - n_mla);
  }
}

template <int TYPE>
DI void attn_item(const Params& p, int l, int bb, int head, int qb, char* smem) {
  constexpr int DK = (TYPE == 0) ? 96 : 64;
  constexpr int KP = DK + 8;
  constexpr int NKS = (TYPE == 0) ? 6 : (TYPE == 1 ? 4 : 2);
  constexpr int NMAP = (TYPE == 2) ? 2 : 1;
  constexpr int KCH = DK / 8;
  constexpr int NKL = (64 * KCH) / 256;
  u16* sK = (u16*)smem;
  u16* sV = sK + 64 * KP;
  const int tid = otid(), lane = tid & 63, wv = tid >> 6, r = lane & 31, h = lane >> 5;
  const int qt0 = qb * 128;
  const int nkeys = (qb < 2) ? 256 : T;
  const u16 *Kg, *Vg, *Qg;
  if (TYPE == 0) { Kg = p.KA + (long)(bb * 4 + head) * T * 96; Vg = p.VAt + (long)(bb * 4 + head) * 64 * T; Qg = p.QA + ((long)(bb * 4 + head) * T + qt0 + wv * 32 + r) * 96; }
  else if (TYPE == 1) { Kg = p.KC + (long)(bb * 2 + (head >> 1)) * T * 64; Vg = p.VCt + (long)(bb * 2 + (head >> 1)) * 64 * T; Qg = p.QC + ((long)(bb * 4 + head) * T + qt0 + wv * 32 + r) * 64; }
  else { Kg = p.KD + (long)(bb * 4 + head) * T * 64; Vg = p.VDt + (long)(bb * 4 + head) * 64 * T; Qg = p.QD + ((long)(bb * 4 + head) * T + qt0 + wv * 32 + r) * 64; }
  bf16x8 qf[NMAP][NKS];
#pragma unroll
  for (int mp = 0; mp < NMAP; mp++)
#pragma unroll
    for (int ks = 0; ks < NKS; ks++) qf[mp][ks] = *(const bf16x8*)(Qg + mp * 32 + ks * 16 + h * 8);
  f32x16 O[NMAP][2];
  float mrun[NMAP], lrun[NMAP];
  f32x16 nm;
#pragma unroll
  for (int i = 0; i < 16; i++) nm[i] = 0.f;
#pragma unroll
  for (int mp = 0; mp < NMAP; mp++) {
    mrun[mp] = (TYPE == 2) ? -1e30f : 0.f; lrun[mp] = 0.f;
#pragma unroll
    for (int d = 0; d < 2; d++)
#pragma unroll
      for (int i = 0; i < 16; i++) O[mp][d][i] = 0.f;
  }
  u32x4 rk[NKL], rv[2];
  auto gload = [&](int key0) {
#pragma unroll
    for (int i = 0; i < NKL; i++) { int c = tid + i * 256; int row = c / KCH, cc = c % KCH; rk[i] = *(const u32x4*)(Kg + (long)(key0 + row) * DK + cc * 8); }
#pragma unroll
    for (int i = 0; i < 2; i++) { int c = tid + i * 256; int row = c >> 3, cc = c & 7; rv[i] = *(const u32x4*)(Vg + (long)row * T + key0 + cc * 8); }
  };
  gload(0);
  const int ntile = nkeys >> 6;
  __syncthreads();
  for (int kt = 0; kt < ntile; kt++) {
#pragma unroll
    for (int i = 0; i < NKL; i++) { int c = tid + i * 256; int row = c / KCH, cc = c % KCH; *(u32x4*)(sK + row * KP + cc * 8) = rk[i]; }
#pragma unroll
    for (int i = 0; i < 2; i++) { int c = tid + i * 256; int row = c >> 3, cc = c & 7; *(u32x4*)(sV + row * 72 + cc * 8) = rv[i]; }
    __syncthreads();
    if (kt + 1 < ntile) gload((kt + 1) * 64);
#pragma unroll
    for (int mp = 0; mp < NMAP; mp++) {
      f32x16 s[2];
#pragma unroll
      for (int kb = 0; kb < 2; kb++) {
#pragma unroll
        for (int ks = 0; ks < NKS; ks++) {
          bf16x8 kf = *(const bf16x8*)(sK + (kb * 32 + r) * KP + mp * 32 + ks * 16 + h * 8);
          if (ks == 0) {
            if (TYPE == 2) { f32x16 z; for (int i = 0; i < 16; i++) z[i] = 0.f; s[kb] = MFMA32(kf, qf[mp][ks], z); }
            else s[kb] = MFMA32(kf, qf[mp][ks], nm);
          } else s[kb] = MFMA32(kf, qf[mp][ks], s[kb]);
        }
      }
      float mx = s[0][0];
#pragma unroll
      for (int i = 1; i < 16; i++) mx = fmaxf(mx, s[0][i]);
#pragma unroll
      for (int i = 0; i < 16; i++) mx = fmaxf(mx, s[1][i]);
      mx = xmax32(mx);
      float psum = 0.f;
      if (TYPE == 2) {
        if (__builtin_amdgcn_ballot_w64(mx > mrun[mp]) != 0ull) {
          float mnew = fmaxf(mrun[mp], mx);
          float alpha = __builtin_amdgcn_exp2f(mrun[mp] - mnew);
          mrun[mp] = mnew;
          lrun[mp] *= alpha;
#pragma unroll
          for (int d = 0; d < 2; d++)
#pragma unroll
            for (int i = 0; i < 16; i++) O[mp][d][i] *= alpha;
        }
        const float mcur = mrun[mp];
#pragma unroll
        for (int kb = 0; kb < 2; kb++)
#pragma unroll
          for (int i = 0; i < 16; i++) { float e = __builtin_amdgcn_exp2f(s[kb][i] - mcur); s[kb][i] = e; psum += e; }
      } else {
        if (__builtin_amdgcn_ballot_w64(mx > 0.f) != 0ull) {
          float delta = fmaxf(mx, 0.f);
          float alpha = __builtin_amdgcn_exp2f(-delta);
          mrun[mp] += delta;
          lrun[mp] *= alpha;
#pragma unroll
          for (int d = 0; d < 2; d++)
#pragma unroll
            for (int i = 0; i < 16; i++) O[mp][d][i] *= alpha;
#pragma unroll
          for (int kb = 0; kb < 2; kb++)
#pragma unroll
            for (int i = 0; i < 16; i++) s[kb][i] -= delta;
          const float nmv = -mrun[mp];
#pragma unroll
          for (int i = 0; i < 16; i++) nm[i] = nmv;
        }
#pragma unroll
        for (int kb = 0; kb < 2; kb++)
#pragma unroll
          for (int i = 0; i < 16; i++) { float e = __builtin_amdgcn_exp2f(s[kb][i]); s[kb][i] = e; psum += e; }
      }
      lrun[mp] += psum;
#pragma unroll
      for (int kb = 0; kb < 2; kb++)
#pragma unroll
        for (int s2 = 0; s2 < 2; s2++) {
          unsigned pw[4];
#pragma unroll
          for (int e = 0; e < 4; e++) pw[e] = pack2(s[kb][8 * s2 + 2 * e], s[kb][8 * s2 + 2 * e + 1]);
          u32x4 pu = u32x4{pw[0], pw[1], pw[2], pw[3]};
          bf16x8 pf = __builtin_bit_cast(bf16x8, pu);
#pragma unroll
          for (int d = 0; d < 2; d++) {
            const u16* vp = sV + (d * 32 + r) * 72 + kb * 32 + s2 * 16 + 4 * h;
            s16x4 vlo = *(const s16x4*)vp, vhi = *(const s16x4*)(vp + 8);
            bf16x8 vf = __builtin_shufflevector(vlo, vhi, 0, 1, 2, 3, 4, 5, 6, 7);
            O[mp][d] = MFMA32(vf, pf, O[mp][d]);
          }
        }
    }
    __syncthreads();
  }
  float inv[NMAP];
#pragma unroll
  for (int mp = 0; mp < NMAP; mp++) { float lt = xsum32(lrun[mp]); inv[mp] = 1.f / lt; }
  const int tid2 = otid();
  const int r2 = tid2 & 31, h2 = (tid2 >> 5) & 1, wv2 = tid2 >> 6;
  const int t = qb * 128 + wv2 * 32 + r2;
  const long mh = (long)bb * T + t;
  const int gcol = (TYPE == 0) ? 0 : (TYPE == 1 ? 512 : 768);
  const int ocol = (TYPE == 0) ? 0 : (TYPE == 1 ? 512 : 768);
  float val[2][16];
  if (TYPE == 2) {
    float lam = p.lam[l], li = p.lam[2 + l];
    float ss = 0.f;
#pragma unroll
    for (int d = 0; d < 2; d++)
#pragma unroll
      for (int i = 0; i < 16; i++) { float x = O[0][d][i] * inv[0] - lam * O[NMAP - 1][d][i] * inv[NMAP - 1]; val[d][i] = x; ss += x * x; }
    ss = xsum32(ss);
    float rs = rsqrtf(ss * (1.f / 64.f) + 1e-5f) * (1.f - li);
    const float* sg = p.in[24] + l * 64;
#pragma unroll
    for (int d = 0; d < 2; d++)
#pragma unroll
      for (int i = 0; i < 16; i++) { int dv = d * 32 + (i & 3) + 8 * (i >> 2) + 4 * h2; val[d][i] *= rs * sg[dv]; }
  } else {
#pragma unroll
    for (int d = 0; d < 2; d++)
#pragma unroll
      for (int i = 0; i < 16; i++) val[d][i] = O[0][d][i] * inv[0];
  }
#pragma unroll
  for (int d = 0; d < 2; d++)
#pragma unroll
    for (int g = 0; g < 4; g++) {
      int dv0 = d * 32 + 8 * g + 4 * h2;
      u32x2 gw = *(const u32x2*)(p.Gs + mh * 1024 + gcol + head * 64 + dv0);
      float g0 = lo_bf(gw.x), g1 = hi_bf(gw.x), g2 = lo_bf(gw.y), g3 = hi_bf(gw.y);
      u32x2 ow;
      ow.x = pack2(val[d][4 * g] * siluf_(g0), val[d][4 * g + 1] * siluf_(g1));
      ow.y = pack2(val[d][4 * g + 2] * siluf_(g2), val[d][4 * g + 3] * siluf_(g3));
      *(u32x2*)(p.o + mh * DM + ocol + head * 64 + dv0) = ow;
    }
}

DI void scan_item(const Params& p, int item, char* smem) {
  float* sIn = (float*)smem;
  float* sY = (float*)(smem + 2 * 16 * 6 * 64 * 4);
  const int tid = otid(), lane = tid & 63, wv = tid >> 6;
  const int bb = item >> 5, hd = (item >> 3) & 3, dir = (item >> 2) & 1, rg = item & 3;
  const int rowl = wv * 4 + (lane >> 4), cg4 = (lane & 15) * 4;
  const u16* SIb = p.SI + ((long)(bb * 4 + hd) * T) * 9 * 64;
  u16* yb = p.yscan + ((long)dir * MH + (long)bb * T) * 256 + hd * 64 + rg * 16;
  auto tof = [&](int s) { return dir == 0 ? s : (s < 256 ? 255 - s : 4607 - s); };
  u32x4 rg_[3];
  auto gload = [&](int ci) {
#pragma unroll
    for (int i = 0; i < 3; i++) {
      int id = tid + i * 256;
      int st = id / 48, rem = id % 48, vec = rem >> 3, part = rem & 7;
      int t = tof(ci * 16 + st);
      int vi = vec < 3 ? vec : vec + 3 * dir;
      rg_[i] = *(const u32x4*)(SIb + ((long)t * 9 + vi) * 64 + part * 8);
    }
  };
  auto lstore = [&](int buf) {
#pragma unroll
    for (int i = 0; i < 3; i++) {
      int id = tid + i * 256;
      int st = id / 48, rem = id % 48, vec = rem >> 3, part = rem & 7;
      h8 hv = __builtin_bit_cast(h8, rg_[i]);
      f8 fv = __builtin_convertvector(hv, f8);
      float* d = sIn + ((buf * 16 + st) * 6 + vec) * 64 + part * 8;
      *(f32x4v*)d = f32x4v{fv[0], fv[1], fv[2], fv[3]};
      *(f32x4v*)(d + 4) = f32x4v{fv[4], fv[5], fv[6], fv[7]};
    }
  };
  f32x2 Sa = {0.f, 0.f}, Sb = {0.f, 0.f};
  __syncthreads();
  gload(0);
  lstore(0);
  __syncthreads();
  __builtin_amdgcn_s_setprio(3);
  const int nch = T / 16;
  const int voff = 128 + rg * 16 + rowl;
  const int l16 = lane & 15;
  struct StepIn { f32x4v r, k, w, d, b; float v; };
  auto ldstep = [&](const float* b) {
    StepIn x;
    x.r = *(const f32x4v*)(b + cg4); x.k = *(const f32x4v*)(b + 64 + cg4); x.v = b[voff];
    x.w = *(const f32x4v*)(b + 192 + cg4); x.d = *(const f32x4v*)(b + 256 + cg4); x.b = *(const f32x4v*)(b + 320 + cg4);
    return x;
  };
  for (int ci = 0; ci < nch; ci++) {
    if (ci + 1 < nch) gload(ci + 1);
    const float* base = sIn + (ci & 1) * 16 * 6 * 64;
    float ykeep = 0.f;
    StepIn cur = ldstep(base);
#pragma unroll
    for (int st = 0; st < 16; st++) {
      StepIn nxt = cur;
      if (st + 1 < 16) nxt = ldstep(base + (st + 1) * 6 * 64);
      f32x2 ra = {cur.r.x, cur.r.y}, rb = {cur.r.z, cur.r.w}, ka = {cur.k.x, cur.k.y}, kb = {cur.k.z, cur.k.w};
      f32x2 wa = {cur.w.x, cur.w.y}, wb = {cur.w.z, cur.w.w}, da = {cur.d.x, cur.d.y}, db = {cur.d.z, cur.d.w};
      f32x2 ba = {cur.b.x, cur.b.y}, bb2 = {cur.b.z, cur.b.w};
      f32x2 pp = Sa * ka + Sb * kb;
      float sa = allreduce16(pp.x + pp.y);
      f32x2 vv2 = {cur.v, cur.v};
      f32x2 sa2 = {sa, sa};
      Sa = (Sa * wa + vv2 * da) - sa2 * ba;
      Sb = (Sb * wb + vv2 * db) - sa2 * bb2;
      f32x2 yy = Sa * ra + Sb * rb;
      float y = allreduce16(yy.x + yy.y);
      ykeep = (l16 == st) ? y : ykeep;
      cur = nxt;
    }
    { _Float16 yh = (_Float16)ykeep; yb[(long)tof(ci * 16 + l16) * 256 + rowl] = __builtin_bit_cast(u16, yh); }
    if (ci + 1 < nch) lstore((ci + 1) & 1);
    __syncthreads();
  }
  __builtin_amdgcn_s_setprio(0);
}

DI void gates_tile(const Params& p, int l, int half, int it, char* smem) {
  u16* sA = (u16*)smem; u16* sW = sA + 256 * 72; float* sC = (float*)smem;
  const int tid = otid();
  int tm = it >> 5, tn = it & 31;
  long row0 = (l == 0) ? (long)tm * 256 : (long)(tm >> 4) * T + 256 + (tm & 15) * 256;
  f32x16 acc[4][2];
#pragma unroll
  for (int a = 0; a < 4; a++)
#pragma unroll
    for (int b = 0; b < 2; b++)
#pragma unroll
      for (int i = 0; i < 16; i++) acc[a][b][i] = 0.f;
  __syncthreads();
  gemm_core256(acc, p.A + ((long)half * MH + row0) * DM, DM, p.Wt_in + ((long)l * NPAD + C_MG + tn * 128) * 1024, 1024, 1024, sA, sW);
  const float* mb = p.in[25] + l * 4096 + tn * 128;
#pragma unroll
  for (int hf = 0; hf < 2; hf++) {
    dump_acc256(acc, sC, hf);
    __syncthreads();
#pragma unroll
    for (int ps = 0; ps < 8; ps++) {
      int row = (tid >> 4) + 16 * ps, ch = tid & 15;
      const float* s = sC + row * CP + ch * 8;
      f32x4v a = *(const f32x4v*)s, b = *(const f32x4v*)(s + 4);
      f32x4v m0 = *(const f32x4v*)(mb + ch * 8), m1 = *(const f32x4v*)(mb + ch * 8 + 4);
      float v[8];
      v[0] = sigmoidf_(a.x + m0.x); v[1] = sigmoidf_(a.y + m0.y); v[2] = sigmoidf_(a.z + m0.z); v[3] = sigmoidf_(a.w + m0.w);
      v[4] = sigmoidf_(b.x + m1.x); v[5] = sigmoidf_(b.y + m1.y); v[6] = sigmoidf_(b.z + m1.z); v[7] = sigmoidf_(b.w + m1.w);
      *(u32x4*)(p.G + (row0 + hf * 128 + row) * 4096 + tn * 128 + ch * 8) = pack8(v);
    }
    __syncthreads();
  }
}

DI void phase_attn_scan(const Params& p, int l, int half, char* smem, int rep) {
  __shared__ int s_item;
  const int n_scan = 128, n_lat = 3 * 512, n_ctx = (l == 0) ? 96 : 0;
  const int n_gate = ((l == 0) ? 68 : 64) * 32;
  const int total = n_scan + n_lat + n_ctx + n_gate;
  unsigned* cnt = p.cnt + (l * 2 + half) + 8 * rep;
  for (;;) {
    __syncthreads();
    if (threadIdx.x == 0) s_item = (int)atomicAdd(cnt, 1u);
    __syncthreads();
    int it = s_item;
    if (it >= total) break;
    if (it < n_scan) { scan_item(p, it, smem); continue; }
    it -= n_scan;
    int type, bb, head, qb;
    if (it < n_lat) {
      int ty = it / 512, q = it % 512;
      type = (ty == 0) ? 2 : (ty == 1 ? 0 : 1);
      qb = 2 + (q & 31); head = (q >> 5) & 3; bb = q >> 7;
    } else if (it >= n_lat + n_ctx) {
      gates_tile(p, l, half, it - n_lat - n_ctx, smem);
      continue;
    } else {
      it -= n_lat;
      int ty = it / 32, q = it % 32;
      type = (ty == 0) ? 2 : (ty == 1 ? 0 : 1);
      qb = q & 1; head = (q >> 1) & 3; bb = q >> 3;
    }
    if (type == 0) attn_item<0>(p, l, bb, head, qb, smem);
    else if (type == 1) attn_item<1>(p, l, bb, head, qb, smem);
    else attn_item<2>(p, l, bb, head, qb, smem);
  }
}

DI void phase_rwkv_post(const Params& p, int l, int half) {
  const int c = otid();
  const float gw = p.in[19][l * 256 + c], gb = p.in[20][l * 256 + c];
  for (int m0 = blockIdx.x * 4; m0 < MH; m0 += gridDim.x * 4) {
    float y[4], bo[4], g[4];
#pragma unroll
    for (int q = 0; q < 4; q++) {
      long mh = m0 + q;
      y[q] = (float)__builtin_bit_cast(_Float16, p.yscan[mh * 256 + c]) + (float)__builtin_bit_cast(_Float16, p.yscan[((long)MH + mh) * 256 + c]);
      bo[q] = p.bonus[mh * 256 + c];
      g[q] = bf2f(p.Gs[mh * 1024 + 256 + c]);
    }
    float mu[4], d[4], var[4];
#pragma unroll
    for (int q = 0; q < 4; q++) mu[q] = wave_sum(y[q]) * (1.f / 64.f);
#pragma unroll
    for (int q = 0; q < 4; q++) { d[q] = y[q] - mu[q]; var[q] = wave_sum(d[q] * d[q]) * (1.f / 64.f); }
#pragma unroll
    for (int q = 0; q < 4; q++) {
      long mh = m0 + q;
      float ob = d[q] * rsqrtf(var[q] + 64e-5f) * gw + gb + bo[q];
      p.o[mh * DM + 256 + c] = f2bf(ob * siluf_(g[q]));
    }
  }
}

DI void phase_merge(const Params& p, int l, int half, char* smem) {
  u16* sA = (u16*)smem; u16* sW = sA + 128 * 72; float* sC = (float*)smem;
  const int tid = otid();
  const int nq = (l == 0) ? 34 : 32;
  const int ntiles = 4 * nq * 8;
  for (int it = blockIdx.x; it < ntiles; it += gridDim.x) {
    int tmi = it >> 3, tn = it & 7;
    int bb = tmi / nq, qb = tmi % nq + (34 - nq);
    long mh0 = (long)bb * T + qb * 128;
    float y[8][8];
#pragma unroll
    for (int a = 0; a < 8; a++)
#pragma unroll
      for (int b = 0; b < 8; b++) y[a][b] = 0.f;
#pragma unroll 1
    for (int i = 0; i < 4; i++) {
      f32x16 acc[2][2];
      zero_acc<2>(acc);
      gemm_core<2>(acc, p.o + mh0 * DM + i * 256, DM, p.Wt_br + (((long)l * 4 + i) * 1024 + tn * 128) * 256, 256, 256, sA, sW);
      dump_acc<2>(acc, sC);
      __syncthreads();
#pragma unroll
      for (int ps = 0; ps < 8; ps++) {
        int row = (tid >> 4) + 16 * ps, ch = tid & 15;
        const float* s = sC + row * CP + ch * 8;
        f32x4v a = *(const f32x4v*)s, b = *(const f32x4v*)(s + 4);
        u32x4 g = *(const u32x4*)(p.G + (mh0 + row) * 4096 + i * 1024 + tn * 128 + ch * 8);
        y[ps][0] += lo_bf(g.x) * a.x; y[ps][1] += hi_bf(g.x) * a.y; y[ps][2] += lo_bf(g.y) * a.z; y[ps][3] += hi_bf(g.y) * a.w;
        y[ps][4] += lo_bf(g.z) * b.x; y[ps][5] += hi_bf(g.z) * b.y; y[ps][6] += lo_bf(g.w) * b.z; y[ps][7] += hi_bf(g.w) * b.w;
      }
      __syncthreads();
    }
#pragma unroll
    for (int ps = 0; ps < 8; ps++) {
      int row = (tid >> 4) + 16 * ps, ch = tid & 15;
      *(u32x4*)(p.ybuf + (mh0 + row) * DM + tn * 128 + ch * 8) = pack8(y[ps]);
    }
  }
}

DI void phase_outproj(const Params& p, int l, int half, char* smem) {
  u16* sA = (u16*)smem; u16* sW = sA + 128 * 72; float* sC = (float*)smem;
  const int tid = otid();
  const int nq = (l == 0) ? 34 : 32;
  const int ntiles = 4 * nq * 8;
  for (int it = blockIdx.x; it < ntiles; it += gridDim.x) {
    int tmi = it >> 3, tn = it & 7;
    int bb = tmi / nq, qb = tmi % nq + (34 - nq);
    long mh0 = (long)bb * T + qb * 128;
    int b = half * HB + bb;
    f32x16 acc[2][2];
    zero_acc<2>(acc);
    gemm_core<2>(acc, p.ybuf + mh0 * DM, DM, p.Wt_out + ((long)l * 1024 + tn * 128) * 1024, 1024, 1024, sA, sW);
    dump_acc<2>(acc, sC);
    __syncthreads();
    const float* gate = p.mod + ((long)l * 9 + (qb < 2 ? 8 : b)) * 3072 + 2048 + tn * 128;
#pragma unroll
    for (int ps = 0; ps < 8; ps++) {
      int row = (tid >> 4) + 16 * ps, ch = tid & 15;
      int t = qb * 128 + row;
      const float* s = sC + row * CP + ch * 8;
      const float* xr = xrow(p, l, b, t) + tn * 128 + ch * 8;
      float* hd = p.hbuf + (mh0 + row) * DM + tn * 128 + ch * 8;
#pragma unroll
      for (int q = 0; q < 2; q++) {
        f32x4v z = *(const f32x4v*)(s + q * 4), x4 = *(const f32x4v*)(xr + q * 4), g4 = *(const f32x4v*)(gate + ch * 8 + q * 4);
        f32x4v o4 = f32x4v{ALPHA_DN * x4.x + g4.x * z.x, ALPHA_DN * x4.y + g4.y * z.y, ALPHA_DN * x4.z + g4.z * z.z, ALPHA_DN * x4.w + g4.w * z.w};
        *(f32x4v*)(hd + q * 4) = o4;
      }
    }
    __syncthreads();
  }
}


#define XB_TMO      128
#define XB_XCNT(j)  (256  + 64 * (j))
#define XB_XSUB(j)  (1280 + 64 * (j))
#define XB_XGEN(j)  (2304 + 64 * (j))
#define XB_TOP      3328
#define XB_TOPGEN   3392
#define XCD_BAR_WORDS 3456
#define XB_SPIN_CAP (1u << 20)
#define LAS __attribute__((address_space(3)))
DI unsigned xb_ld(unsigned* p) { return __hip_atomic_load(p, __ATOMIC_RELAXED, __HIP_MEMORY_SCOPE_AGENT); }
DI unsigned xb_add(unsigned* p, unsigned v) { return __hip_atomic_fetch_add(p, v, __ATOMIC_RELAXED, __HIP_MEMORY_SCOPE_AGENT); }
DI unsigned xb_xcc_id() { return (unsigned)__builtin_amdgcn_s_getreg((3 << 11) | 20) & 0xFu; }
#define XB_SPIN(cond, bar) do { unsigned _sp = 0; while (cond) { __builtin_amdgcn_s_sleep(1); \
    if ((++_sp & 255u) == 0u) { if (xb_ld(&(bar)[XB_TMO])) break; if (_sp > XB_SPIN_CAP) { atomicAdd(&(bar)[XB_TMO], 1u); break; } } } } while (0)
struct XcdBarrier { unsigned* bar; unsigned x; volatile LAS unsigned* st; };
DI XcdBarrier xcd_barrier_post(unsigned* bar, volatile LAS unsigned* st) {
  XcdBarrier b; b.bar = bar; b.x = xb_xcc_id(); b.st = st;
  if (threadIdx.x == 0) (void)xb_add(&bar[XB_XCNT(b.x)], 1u);
  return b;
}
DI void xcd_barrier_complete(unsigned* bar, unsigned x, unsigned& nloc, unsigned& nx) {
  const unsigned G = gridDim.x * gridDim.y * gridDim.z;
  unsigned sum, cnt, mine, sp = 0u;
  for (;;) {
    sum = 0u; cnt = 0u; mine = 0u;
#pragma unroll
    for (unsigned j = 0; j < 16; ++j) { const unsigned c = xb_ld(&bar[XB_XCNT(j)]); sum += c; cnt += (c > 0u) ? 1u : 0u; mine = (j == x) ? c : mine; }
    if (sum == G) break;
    __builtin_amdgcn_s_sleep(1);
    if ((++sp & 255u) == 0u) { if (xb_ld(&bar[XB_TMO])) break; if (sp > XB_SPIN_CAP) { atomicAdd(&bar[XB_TMO], 1u); break; } }
  }
  nloc = mine > 0u ? mine : 1u; nx = cnt > 0u ? cnt : 1u;
}
DI void xcd_barrier(const XcdBarrier& b) {
  asm volatile("s_waitcnt vmcnt(0)" ::: "memory");
  __syncthreads();
  if (threadIdx.x == 0) {
    unsigned* bar = b.bar;
    __builtin_amdgcn_s_waitcnt(0);
    unsigned nloc = b.st[0], nx = b.st[1];
    if (nloc == 0u) { xcd_barrier_complete(bar, b.x, nloc, nx); b.st[0] = nloc; b.st[1] = nx; }
    const unsigned old = xb_add(&bar[XB_XSUB(b.x)], 1u);
    const unsigned gen = old / nloc;
    if (old + 1u == (gen + 1u) * nloc) {
      __builtin_amdgcn_fence(__ATOMIC_RELEASE, "agent");
      asm volatile("s_waitcnt vmcnt(0)" ::: "memory");
      const unsigned og = xb_add(&bar[XB_TOP], 1u);
      const unsigned tg = og / nx;
      if (og + 1u == (tg + 1u) * nx) xb_add(&bar[XB_TOPGEN], 1u);
      else XB_SPIN(xb_ld(&bar[XB_TOPGEN]) == tg, bar);
      __builtin_amdgcn_fence(__ATOMIC_ACQUIRE, "agent");
      xb_add(&bar[XB_XGEN(b.x)], 1u);
      asm volatile("s_waitcnt vmcnt(0)" ::: "memory");
    } else {
      XB_SPIN(xb_ld(&bar[XB_XGEN(b.x)]) == gen, bar);
      __builtin_amdgcn_fence(__ATOMIC_ACQUIRE, "agent");
      asm volatile("s_waitcnt vmcnt(0)" ::: "memory");
    }
  }
  __syncthreads();
}

constexpr int NSTEPS = 2 + 2 * 2 * (7 + (REPEAT_PH >= 0 ? 1 : 0));
DI void run_step(const Params& p, int s, char* smem) {
  if (s == 0) { phase_prologue(p, smem); return; }
  if (s == 1) { phase_rows(p, 0, 0); return; }
  int q = s - 2;
  constexpr int PER = 7 + (REPEAT_PH >= 0 ? 1 : 0);
  int l = q / (2 * PER), half = (q / PER) % 2, idx = q % PER;
  int ph = (REPEAT_PH >= 0 && idx > REPEAT_PH) ? idx - 1 : idx;
  int rep = (REPEAT_PH >= 0 && idx == REPEAT_PH + 1) ? 1 : 0;
  switch (ph) {
    case 0: phase_inproj(p, l, half, smem); break;
    case 1: phase_prep(p, l, half, smem); break;
    case 2: phase_attn_scan(p, l, half, smem, rep); break;
    case 3: phase_rwkv_post(p, l, half); break;
    case 4: phase_merge(p, l, half, smem); break;
    case 5: phase_outproj(p, l, half, smem); break;
    default: phase_rows(p, l + 1, half); break;
  }
}

__global__ void __launch_bounds__(256, 2) mega(Params p, int s_lo, int s_hi) {
  __shared__ __attribute__((aligned(16))) char smem[SMEM_BYTES];
  __shared__ u32x4 xb_words;
  if (threadIdx.x == 0) xb_words = u32x4{0u, 0u, 0u, 0u};
  __syncthreads();
  XcdBarrier xb = xcd_barrier_post(p.bar, (volatile LAS unsigned*)&xb_words);
  if (s_hi < 0) cg::this_grid().sync();
  for (int s = s_lo; s < s_hi; s++) {
    run_step(p, s, smem);
    if (s + 1 < s_hi) xcd_barrier(xb);
  }
}

extern "C" void kernel_launch(void* const* d_in, const int* in_sizes, int n_in, void* d_out, int out_size,
                              void* d_ws, size_t ws_size, hipStream_t stream) {
  static int grid_blocks = 0;
  if (!grid_blocks) {
    int dev = 0, cus = 0, per_cu = 0;
    (void)hipGetDevice(&dev);
    (void)hipDeviceGetAttribute(&cus, hipDeviceAttributeMultiprocessorCount, dev);
    (void)hipOccupancyMaxActiveBlocksPerMultiprocessor(&per_cu, mega, 256, 0);
    if (per_cu > 2) per_cu = 2;
    if (per_cu < 1) per_cu = 1;
    grid_blocks = cus * per_cu;
  }
  Params p{};
  for (int i = 0; i < 30; i++) p.in[i] = (const float*)d_in[i];
  p.out = (float*)d_out;
  char* w = (char*)d_ws;
  size_t off = 0;
  auto take = [&](size_t bytes) { char* r = w + off; off += (bytes + 255) & ~(size_t)255; return r; };
  p.Wt_in = (u16*)take((size_t)2 * NPAD * 1024 * 2);
  p.Wt_uq = (u16*)take((size_t)2 * 384 * 256 * 2);
  p.Wt_ukv = (u16*)take((size_t)2 * 512 * 128 * 2);
  p.Wt_br = (u16*)take((size_t)2 * 4 * 1024 * 256 * 2);
  p.Wt_out = (u16*)take((size_t)2 * 1024 * 1024 * 2);
  p.Wl = (u16*)take((size_t)2 * 4 * 256 * 64 * 2);
  p.mod = (float*)take((size_t)2 * 9 * 3072 * 4);
  p.rope16 = (float*)take(64 * 16 * 2 * 4);
  p.rope8 = (float*)take(64 * 8 * 2 * 4);
  p.lam = (float*)take(256);
  p.cnt = (unsigned*)take(256);
  p.bar = (unsigned*)take(XCD_BAR_WORDS * 4);
  p.A = (u16*)take((size_t)MT * DM * 2);
  p.ctx1 = (float*)take((size_t)NB * 256 * DM * 4);
  p.P = (u16*)take((size_t)MH * 4096 * 2);
  p.QA = (u16*)take((size_t)HB * 4 * T * 96 * 2);
  p.KA = (u16*)take((size_t)HB * 4 * T * 96 * 2);
  p.VAt = (u16*)take((size_t)HB * 4 * 64 * T * 2);
  p.QC = (u16*)take((size_t)HB * 4 * T * 64 * 2);
  p.KC = (u16*)take((size_t)HB * 2 * T * 64 * 2);
  p.VCt = (u16*)take((size_t)HB * 2 * 64 * T * 2);
  p.QD = (u16*)take((size_t)HB * 4 * T * 64 * 2);
  p.KD = (u16*)take((size_t)HB * 4 * T * 64 * 2);
  p.VDt = (u16*)take((size_t)HB * 4 * 64 * T * 2);
  p.SI = (u16*)take((size_t)HB * 4 * T * 9 * 64 * 2);
  p.bonus = (float*)take((size_t)MH * 256 * 4);
  p.yscan = (u16*)take((size_t)2 * MH * 256 * 2);
  p.Gs = (u16*)take((size_t)MH * 1024 * 2);
  p.o = (u16*)take((size_t)MH * DM * 2);
  p.G = p.P;
  p.ybuf = p.SI;
  p.hbuf = (float*)p.QA;
  if (off > ws_size) fprintf(stderr, "workspace too small: need %zu have %zu\n", off, ws_size);
  (void)hipMemsetAsync(p.cnt, 0, 256 + ((XCD_BAR_WORDS * 4 + 255) & ~255), stream);
#if MULTI_LAUNCH
  for (int s = 0; s < NSTEPS; s++) {
    hipLaunchKernelGGL(mega, dim3(grid_blocks), dim3(256), 0, stream, p, s, s + 1);
  }
#else
  int s_lo = 0, s_hi = NSTEPS;
  void* args[] = {&p, &s_lo, &s_hi};
  hipError_t e = hipLaunchCooperativeKernel((void*)mega, dim3(grid_blocks), dim3(256), args, 0, stream);
  if (e != hipSuccess) fprintf(stderr, "coop launch failed: %s (grid %d)\n", hipGetErrorString(e), grid_blocks);
#endif
}
```

```cpp
#include <hip/hip_runtime.h>
#include <hip/hip_cooperative_groups.h>
#include <cstdio>
namespace cg = cooperative_groups;

#ifndef REPEAT_PH
#define REPEAT_PH -1
#endif
#ifndef MULTI_LAUNCH
#define MULTI_LAUNCH 0
#endif

typedef unsigned short u16;
typedef __attribute__((ext_vector_type(8))) short bf16x8;
typedef __attribute__((ext_vector_type(4))) short s16x4;
typedef __attribute__((ext_vector_type(16))) float f32x16;
typedef __attribute__((ext_vector_type(2))) __bf16 bf16x2_t;
typedef __attribute__((ext_vector_type(2))) float f32x2;
typedef __attribute__((ext_vector_type(8))) _Float16 h8;
typedef __attribute__((ext_vector_type(8))) float f8;
typedef __attribute__((ext_vector_type(4))) unsigned u32x4;
typedef __attribute__((ext_vector_type(2))) unsigned u32x2;
typedef __attribute__((ext_vector_type(4))) float f32x4v;
#define DI __device__ __forceinline__
#define MFMA32(a, b, c) __builtin_amdgcn_mfma_f32_32x32x16_bf16((a), (b), (c), 0, 0, 0)

constexpr int NB = 8, T = 4352, DM = 1024, HB = 4, MH = HB * T, MT = NB * T;
constexpr int NPAD = 7936, NP1 = 3840;
constexpr int C_QLAT = 0, C_KVLAT = 256, C_KROPE = 384, C_GA = 512, C_SH = 768, C_GB = 1792, C_QC = 2048, C_KC = 2304,
              C_VC = 2432, C_GC = 2560, C_QD = 2816, C_KD = 3072, C_VD = 3328, C_GD = 3584, C_MG = 3840;
constexpr float LOG2E = 1.4426950408889634f;
constexpr float ALPHA_DN = 1.4142135623730951f;
constexpr int SMEM_BYTES = 73728 + 1024;
constexpr int CP = 132;

struct Params {
  const float* in[30];
  float* out;
  u16 *Wt_in, *Wt_uq, *Wt_ukv, *Wt_br, *Wt_out, *Wl;
  float *mod, *rope16, *rope8, *lam;
  unsigned* cnt;
  unsigned* bar;
  u16* A;
  float* ctx1;
  u16* P;
  u16* G;
  u16 *QA, *KA, *VAt, *QC, *KC, *VCt, *QD, *KD, *VDt;
  u16* SI;
  float* bonus;
  u16* yscan;
  u16* Gs;
  u16* o;
  u16* ybuf;
  float* hbuf;
};

DI int otid() { int t; asm volatile("v_mov_b32 %0, %1" : "=v"(t) : "v"((int)threadIdx.x)); return t; }
DI float bf2f(u16 x) { return __uint_as_float(((unsigned)x) << 16); }
DI unsigned pack2(float a, float b) {
  f32x2 v = {a, b};
  bf16x2_t r = __builtin_convertvector(v, bf16x2_t);
  return __builtin_bit_cast(unsigned, r);
}
DI u16 f2bf(float a) { return (u16)(pack2(a, 0.f) & 0xffffu); }
DI float lo_bf(unsigned w) { return __uint_as_float(w << 16); }
DI float hi_bf(unsigned w) { return __uint_as_float(w & 0xffff0000u); }
DI float sigmoidf_(float x) { return __builtin_amdgcn_rcpf(1.f + __builtin_amdgcn_exp2f(-1.4426950408889634f * x)); }
DI float siluf_(float x) { return x * __builtin_amdgcn_rcpf(1.f + __builtin_amdgcn_exp2f(-1.4426950408889634f * x)); }
DI float allreduce16(float x) {
  x += __int_as_float(__builtin_amdgcn_mov_dpp(__float_as_int(x), 0xB1, 0xf, 0xf, true));
  x += __int_as_float(__builtin_amdgcn_mov_dpp(__float_as_int(x), 0x4E, 0xf, 0xf, true));
  x += __int_as_float(__builtin_amdgcn_mov_dpp(__float_as_int(x), 0x141, 0xf, 0xf, true));
  x += __int_as_float(__builtin_amdgcn_mov_dpp(__float_as_int(x), 0x140, 0xf, 0xf, true));
  return x;
}
DI float xsum32(float x) { auto r = __builtin_amdgcn_permlane32_swap(__float_as_uint(x), __float_as_uint(x), false, false); return __uint_as_float(r[0]) + __uint_as_float(r[1]); }
DI float xmax32(float x) { auto r = __builtin_amdgcn_permlane32_swap(__float_as_uint(x), __float_as_uint(x), false, false); return fmaxf(__uint_as_float(r[0]), __uint_as_float(r[1])); }
DI float xsum16(float x) { auto r = __builtin_amdgcn_permlane16_swap(__float_as_uint(x), __float_as_uint(x), false, false); return __uint_as_float(r[0]) + __uint_as_float(r[1]); }
DI float wave_sum(float v) { return xsum32(xsum16(allreduce16(v))); }
DI void unpack8(const u32x4& u, float* v) {
  v[0] = lo_bf(u.x); v[1] = hi_bf(u.x); v[2] = lo_bf(u.y); v[3] = hi_bf(u.y);
  v[4] = lo_bf(u.z); v[5] = hi_bf(u.z); v[6] = lo_bf(u.w); v[7] = hi_bf(u.w);
}
DI u32x4 pack8(const float* v) {
  u32x4 u;
  u.x = pack2(v[0], v[1]); u.y = pack2(v[2], v[3]); u.z = pack2(v[4], v[5]); u.w = pack2(v[6], v[7]);
  return u;
}
DI const float* xrow(const Params& p, int l, int b, int t) {
  if (l == 0) return t < 256 ? p.in[2] + ((long)b * 256 + t) * DM : p.in[0] + ((long)b * 4096 + (t - 256)) * DM;
  return t < 256 ? p.ctx1 + ((long)b * 256 + t) * DM : p.out + ((long)b * 4096 + (t - 256)) * DM;
}

template <int NI>
DI void gemm_core(f32x16 (&acc)[2][NI], const u16* __restrict__ A, int lda, const u16* __restrict__ W, int ldw, int K,
                  u16* sA0, u16* sW0) {
  constexpr int GBUF = 2 * 128 * 72;
  const int tid = otid(), lane = tid & 63, wv = tid >> 6, wm = wv >> 1, wn = wv & 1;
  const int r = lane & 31, h = lane >> 5;
  const int lc = tid & 7, lr = tid >> 3;
  const unsigned aoff = (unsigned)(lr * lda + lc * 8);
  const unsigned woff = (unsigned)(lr * ldw + lc * 8);
  u32x4 raA[4], rwA[2 * NI], raB[4], rwB[2 * NI];
#define G_LOAD(RA, RW, kt_) { _Pragma("unroll") for (int i = 0; i < 4; i++) { \
      RA[i] = *(const u32x4*)(A + (aoff + (unsigned)(i * 32 * lda) + (unsigned)((kt_) * 64))); \
      if (i < 2 * NI) RW[i] = *(const u32x4*)(W + (woff + (unsigned)(i * 32 * ldw) + (unsigned)((kt_) * 64))); } }
#define G_STORE(RA, RW, buf_) { u16* dA = sA0 + (buf_) * GBUF; u16* dW = sW0 + (buf_) * GBUF; _Pragma("unroll") for (int i = 0; i < 4; i++) { \
      *(u32x4*)(dA + (lr + i * 32) * 72 + lc * 8) = RA[i]; \
      if (i < 2 * NI) *(u32x4*)(dW + (lr + i * 32) * 72 + lc * 8) = RW[i]; } }
#define G_COMPUTE(buf_) { const u16* sA = sA0 + (buf_) * GBUF; const u16* sW = sW0 + (buf_) * GBUF; _Pragma("unroll") for (int ks = 0; ks < 4; ks++) { \
      bf16x8 af[2], bfv[NI]; \
      _Pragma("unroll") for (int mi = 0; mi < 2; mi++) af[mi] = *(const bf16x8*)(sA + (wm * 64 + mi * 32 + r) * 72 + ks * 16 + h * 8); \
      _Pragma("unroll") for (int ni = 0; ni < NI; ni++) bfv[ni] = *(const bf16x8*)(sW + (wn * 32 * NI + ni * 32 + r) * 72 + ks * 16 + h * 8); \
      _Pragma("unroll") for (int mi = 0; mi < 2; mi++) _Pragma("unroll") for (int ni = 0; ni < NI; ni++) acc[mi][ni] = MFMA32(af[mi], bfv[ni], acc[mi][ni]); } }
  const int nk = K >> 6;
  G_LOAD(raA, rwA, 0)
  G_STORE(raA, rwA, 0)
  G_LOAD(raA, rwA, 1)
  if (nk > 2) G_LOAD(raB, rwB, 2)
  __syncthreads();
  for (int kt = 0; kt < nk; kt += 2) {
    G_STORE(raA, rwA, 1)
    if (kt + 3 < nk) G_LOAD(raA, rwA, kt + 3)
    G_COMPUTE(0)
    __syncthreads();
    if (kt + 2 < nk) G_STORE(raB, rwB, 0)
    if (kt + 4 < nk) G_LOAD(raB, rwB, kt + 4)
    G_COMPUTE(1)
    __syncthreads();
  }
#undef G_LOAD
#undef G_STORE
#undef G_COMPUTE
}
template <int NI>
DI void zero_acc(f32x16 (&acc)[2][NI]) {
#pragma unroll
  for (int a = 0; a < 2; a++)
#pragma unroll
    for (int b = 0; b < NI; b++)
#pragma unroll
      for (int i = 0; i < 16; i++) acc[a][b][i] = 0.f;
}
template <int NI>
DI void dump_acc(const f32x16 (&acc)[2][NI], float* sC) {
  const int tid = otid(), lane = tid & 63, wv = tid >> 6, wm = wv >> 1, wn = wv & 1;
  const int r = lane & 31, h = lane >> 5;
#pragma unroll
  for (int mi = 0; mi < 2; mi++)
#pragma unroll
    for (int ni = 0; ni < NI; ni++)
#pragma unroll
      for (int i = 0; i < 16; i++) {
        int row = wm * 64 + mi * 32 + (i & 3) + 8 * (i >> 2) + 4 * h;
        int col = wn * 32 * NI + ni * 32 + r;
        sC[row * CP + col] = acc[mi][ni][i];
      }
}


DI void gemm_core256(f32x16 (&acc)[4][2], const u16* __restrict__ A, int lda, const u16* __restrict__ W, int ldw, int K,
                     u16* sA, u16* sW) {
  const int tid = otid(), lane = tid & 63, wv = tid >> 6, wm = wv >> 1, wn = wv & 1;
  const int r = lane & 31, h = lane >> 5;
  const int lc = tid & 7, lr = tid >> 3;
  const unsigned aoff = (unsigned)(lr * lda + lc * 8);
  const unsigned woff = (unsigned)(lr * ldw + lc * 8);
  u32x4 ra[8], rw[4];
#pragma unroll
  for (int i = 0; i < 8; i++) {
    ra[i] = *(const u32x4*)(A + (aoff + (unsigned)(i * 32 * lda)));
    if (i < 4) rw[i] = *(const u32x4*)(W + (woff + (unsigned)(i * 32 * ldw)));
  }
  const int nk = K >> 6;
  for (int kt = 0; kt < nk; kt++) {
#pragma unroll
    for (int i = 0; i < 8; i++) {
      *(u32x4*)(sA + (lr + i * 32) * 72 + lc * 8) = ra[i];
      if (i < 4) *(u32x4*)(sW + (lr + i * 32) * 72 + lc * 8) = rw[i];
    }
    __syncthreads();
    if (kt + 1 < nk) {
#pragma unroll
      for (int i = 0; i < 8; i++) {
        ra[i] = *(const u32x4*)(A + (aoff + (unsigned)(i * 32 * lda) + (unsigned)((kt + 1) * 64)));
        if (i < 4) rw[i] = *(const u32x4*)(W + (woff + (unsigned)(i * 32 * ldw) + (unsigned)((kt + 1) * 64)));
      }
    }
#pragma unroll
    for (int ks = 0; ks < 4; ks++) {
      bf16x8 af[4], bfv[2];
#pragma unroll
      for (int mi = 0; mi < 4; mi++) af[mi] = *(const bf16x8*)(sA + (wm * 128 + mi * 32 + r) * 72 + ks * 16 + h * 8);
#pragma unroll
      for (int ni = 0; ni < 2; ni++) bfv[ni] = *(const bf16x8*)(sW + (wn * 64 + ni * 32 + r) * 72 + ks * 16 + h * 8);
#pragma unroll
      for (int mi = 0; mi < 4; mi++)
#pragma unroll
        for (int ni = 0; ni < 2; ni++) acc[mi][ni] = MFMA32(af[mi], bfv[ni], acc[mi][ni]);
    }
    __syncthreads();
  }
}
DI void dump_acc256(const f32x16 (&acc)[4][2], float* sC, int hf) {
  const int tid = otid(), lane = tid & 63, wv = tid >> 6, wm = wv >> 1, wn = wv & 1;
  const int r = lane & 31, h = lane >> 5;
  if (wm == hf) {
#pragma unroll
    for (int mi = 0; mi < 4; mi++)
#pragma unroll
      for (int ni = 0; ni < 2; ni++)
#pragma unroll
        for (int i = 0; i < 16; i++) {
          int row = mi * 32 + (i & 3) + 8 * (i >> 2) + 4 * h;
          int col = wn * 64 + ni * 32 + r;
          sC[row * CP + col] = acc[mi][ni][i];
        }
  }
}
template <int MODE>
DI int colmap(int n) {
  if (MODE == 0) return n < 416 ? n : (n < 512 ? -1 : n - 96);
  if (MODE == 1) return n < 256 ? (n >> 6) * 96 + (n & 63) : ((n - 256) >> 5) * 96 + 64 + ((n - 256) & 31);
  if (MODE == 2) return n < 256 ? (n >> 6) * 128 + (n & 63) : ((n - 256) >> 6) * 128 + 64 + ((n - 256) & 63);
  return n;
}
template <int MODE>
DI void conv_weight(u16* dst, const float* src, int Np, int K, int ld, const float* rowscale, long gtid, long gsz) {
  long total = (long)Np * (K / 8);
  for (long j = gtid; j < total; j += gsz) {
    int n = (int)(j % Np), kc = (int)(j / Np);
    int c = colmap<MODE>(n);
    float v[8];
#pragma unroll
    for (int q = 0; q < 8; q++) {
      int k = kc * 8 + q;
      float x = (c >= 0) ? src[(long)k * ld + c] : 0.f;
      if (rowscale) x *= rowscale[k];
      v[q] = x;
    }
    *(u32x4*)(dst + (long)n * K + kc * 8) = pack8(v);
  }
}

DI void conv_layer(const Params& p, int l, long gtid, long gsz) {
  conv_weight<0>(p.Wt_in + (long)l * NPAD * 1024, p.in[6] + (long)l * 1024 * 7840, NPAD, 1024, 7840, nullptr, gtid, gsz);
  conv_weight<1>(p.Wt_uq + (long)l * 384 * 256, p.in[8] + (long)l * 256 * 384, 384, 256, 384, p.in[7] + l * 256, gtid, gsz);
  conv_weight<2>(p.Wt_ukv + (long)l * 512 * 128, p.in[10] + (long)l * 128 * 512, 512, 128, 512, p.in[9] + l * 128, gtid, gsz);
  for (int i = 0; i < 4; i++)
    conv_weight<3>(p.Wt_br + ((long)l * 4 + i) * 1024 * 256, p.in[26] + ((long)l * 4 + i) * 256 * 1024, 1024, 256, 1024, nullptr, gtid, gsz);
  conv_weight<3>(p.Wt_out + (long)l * 1024 * 1024, p.in[27] + (long)l * 1024 * 1024, 1024, 1024, 1024, nullptr, gtid, gsz);
  for (int d = 0; d < 2; d++) {
    conv_weight<3>(p.Wl + ((long)l * 4 + d) * 256 * 64, p.in[13] + ((long)l * 2 + d) * 64 * 256, 256, 64, 256, nullptr, gtid, gsz);
    conv_weight<3>(p.Wl + ((long)l * 4 + 2 + d) * 256 * 64, p.in[15] + ((long)l * 2 + d) * 64 * 256, 256, 64, 256, nullptr, gtid, gsz);
  }
}
DI void phase_prologue(const Params& p, char* smem) {
  const long gsz = (long)gridDim.x * blockDim.x, gtid = (long)blockIdx.x * blockDim.x + otid();
  conv_layer(p, 0, gtid, gsz);
  if (blockIdx.x == 0) {
    int tid = otid();
    for (int e = tid; e < 64 * 16; e += 256) {
      int pos = e >> 4, j = e & 15;
      float inv = exp2f(-(float)j * (13.287712379549449f / 16.f));
      float rev = (float)pos * inv * 0.15915494309189535f;
      rev = rev - floorf(rev);
      p.rope16[2 * e] = __builtin_amdgcn_cosf(rev);
      p.rope16[2 * e + 1] = __builtin_amdgcn_sinf(rev);
    }
    for (int e = tid; e < 64 * 8; e += 256) {
      int pos = e >> 3, j = e & 7;
      float inv = exp2f(-(float)j * (13.287712379549449f / 8.f));
      float rev = (float)pos * inv * 0.15915494309189535f;
      rev = rev - floorf(rev);
      p.rope8[2 * e] = __builtin_amdgcn_cosf(rev);
      p.rope8[2 * e + 1] = __builtin_amdgcn_sinf(rev);
    }
    if (tid < 2) {
      const float* dl = p.in[23] + tid * 128;
      float s1 = 0.f, s2 = 0.f;
      for (int i = 0; i < 32; i++) { s1 += dl[i] * dl[32 + i]; s2 += dl[64 + i] * dl[96 + i]; }
      float li = 0.8f - 0.6f * expf(-0.3f * (float)tid);
      p.lam[tid] = expf(s1) - expf(s2) + li;
      p.lam[2 + tid] = li;
    }
  }
  float* sc = (float*)smem;
  float* sp = sc + 9 * 1024;
  for (int it = blockIdx.x; it < 192; it += gridDim.x) {
    int l = it / 96, nb = it % 96;
    int tid = otid();
    __syncthreads();
    for (int e = tid; e < 9 * 1024; e += 256) {
      int j = e >> 10, k = e & 1023;
      float cv = j < 8 ? p.in[1][j * 1024 + k] : p.in[3][k];
      sc[e] = siluf_(cv);
    }
    __syncthreads();
    int col = tid & 31, kq = tid >> 5;
    int n = nb * 32 + col;
    const float* w = p.in[4] + (long)l * 1024 * 3072 + n;
    float acc[9];
#pragma unroll
    for (int j = 0; j < 9; j++) acc[j] = 0.f;
    for (int k0 = kq * 128; k0 < kq * 128 + 128; k0 += 16) {
      float wv[16];
#pragma unroll
      for (int q = 0; q < 16; q++) wv[q] = w[(long)(k0 + q) * 3072];
#pragma unroll
      for (int q = 0; q < 16; q++)
#pragma unroll
        for (int j = 0; j < 9; j++) acc[j] += sc[j * 1024 + k0 + q] * wv[q];
    }
#pragma unroll
    for (int j = 0; j < 9; j++) sp[(kq * 9 + j) * 32 + col] = acc[j];
    __syncthreads();
    for (int e = tid; e < 9 * 32; e += 256) {
      int j = e >> 5, c2 = e & 31;
      float sacc = 0.f;
#pragma unroll
      for (int q = 0; q < 8; q++) sacc += sp[(q * 9 + j) * 32 + c2];
      int n2 = nb * 32 + c2;
      p.mod[((long)l * 9 + j) * 3072 + n2] = sacc + p.in[5][l * 3072 + n2];
    }
  }
}

DI void phase_rows(const Params& p, int mode, int half) {
  const int tid_ = otid(); const int lane = tid_ & 63, wv = tid_ >> 6;
  const int nrows = (mode == 0) ? MT : MH;
  const int gw = blockIdx.x * 4 + wv, nw = gridDim.x * 4;
  for (int rr = gw; rr < nrows; rr += nw) {
    int m = (mode == 0) ? rr : half * MH + rr;
    int b = m / T, t = m % T;
    if (mode == 2 && t < 256) continue;
    const float* src = (mode == 0) ? xrow(p, 0, b, t) : p.hbuf + (long)rr * DM;
    float v[16];
#pragma unroll
    for (int q = 0; q < 4; q++) {
      f32x4v x4 = *(const f32x4v*)(src + q * 256 + lane * 4);
      v[q * 4] = x4.x; v[q * 4 + 1] = x4.y; v[q * 4 + 2] = x4.z; v[q * 4 + 3] = x4.w;
    }
    if (mode >= 1) {
      int l = mode - 1;
      float s = 0.f;
#pragma unroll
      for (int i = 0; i < 16; i++) s += v[i];
      float mu = wave_sum(s) * (1.f / 1024.f);
      float s2 = 0.f;
#pragma unroll
      for (int i = 0; i < 16; i++) { float d = v[i] - mu; s2 += d * d; }
      float rs = rsqrtf(wave_sum(s2) * (1.f / 1024.f) + 1e-5f);
      const float* g = p.in[28] + l * 1024;
      const float* bb = p.in[29] + l * 1024;
      float* dst = (mode == 2) ? p.out + ((long)b * 4096 + (t - 256)) * DM
                               : (t < 256 ? p.ctx1 + ((long)b * 256 + t) * DM : p.out + ((long)b * 4096 + (t - 256)) * DM);
#pragma unroll
      for (int q = 0; q < 4; q++) {
        int c = q * 256 + lane * 4;
        f32x4v g4 = *(const f32x4v*)(g + c), b4 = *(const f32x4v*)(bb + c);
        v[q * 4] = (v[q * 4] - mu) * rs * g4.x + b4.x;
        v[q * 4 + 1] = (v[q * 4 + 1] - mu) * rs * g4.y + b4.y;
        v[q * 4 + 2] = (v[q * 4 + 2] - mu) * rs * g4.z + b4.z;
        v[q * 4 + 3] = (v[q * 4 + 3] - mu) * rs * g4.w + b4.w;
        *(f32x4v*)(dst + c) = f32x4v{v[q * 4], v[q * 4 + 1], v[q * 4 + 2], v[q * 4 + 3]};
      }
    }
    if (mode <= 1) {
      int l = mode;
      float s = 0.f;
#pragma unroll
      for (int i = 0; i < 16; i++) s += v[i];
      float mu = wave_sum(s) * (1.f / 1024.f);
      float s2 = 0.f;
#pragma unroll
      for (int i = 0; i < 16; i++) { float d = v[i] - mu; s2 += d * d; }
      float rs = rsqrtf(wave_sum(s2) * (1.f / 1024.f) + 1e-6f);
      const float* md = p.mod + ((long)l * 9 + (t < 256 ? 8 : b)) * 3072;
      u16* dst = p.A + (long)m * DM;
#pragma unroll
      for (int q = 0; q < 4; q++) {
        int c = q * 256 + lane * 4;
        f32x4v sh4 = *(const f32x4v*)(md + c), sc4 = *(const f32x4v*)(md + 1024 + c);
        float a0 = (v[q * 4] - mu) * rs * (1.f + sc4.x) + sh4.x;
        float a1 = (v[q * 4 + 1] - mu) * rs * (1.f + sc4.y) + sh4.y;
        float a2 = (v[q * 4 + 2] - mu) * rs * (1.f + sc4.z) + sh4.z;
        float a3 = (v[q * 4 + 3] - mu) * rs * (1.f + sc4.w) + sh4.w;
        u32x2 o2; o2.x = pack2(a0, a1); o2.y = pack2(a2, a3);
        *(u32x2*)(dst + c) = o2;
      }
    }
  }
}

DI void phase_inproj(const Params& p, int l, int half, char* smem) {
  u16* sA = (u16*)smem; u16* sW = sA + 256 * 72; float* sC = (float*)smem;
  const int tid = otid();
  const int ntiles = 68 * 30;
  for (int it = blockIdx.x; it < ntiles; it += gridDim.x) {
    int tm = it / 30, tn = it % 30;
    f32x16 acc[4][2];
#pragma unroll
    for (int a = 0; a < 4; a++)
#pragma unroll
      for (int b = 0; b < 2; b++)
#pragma unroll
        for (int i = 0; i < 16; i++) acc[a][b][i] = 0.f;
    gemm_core256(acc, p.A + ((long)half * MH + tm * 256) * DM, DM, p.Wt_in + ((long)l * NPAD + tn * 128) * 1024, 1024, 1024, sA, sW);
#pragma unroll
    for (int hf = 0; hf < 2; hf++) {
      dump_acc256(acc, sC, hf);
      __syncthreads();
#pragma unroll
      for (int ps = 0; ps < 8; ps++) {
        int row = (tid >> 4) + 16 * ps, ch = tid & 15;
        const float* s = sC + row * CP + ch * 8;
        float v[8];
        f32x4v a = *(const f32x4v*)s, b = *(const f32x4v*)(s + 4);
        v[0] = a.x; v[1] = a.y; v[2] = a.z; v[3] = a.w; v[4] = b.x; v[5] = b.y; v[6] = b.z; v[7] = b.w;
        {
          int gsel = (tn == 4 || tn == 5) ? 0 : (tn == 14 || tn == 15) ? 1 : (tn == 20 || tn == 21) ? 2 : (tn == 28 || tn == 29) ? 3 : -1;
          if (gsel >= 0) *(u32x4*)(p.Gs + ((long)tm * 256 + hf * 128 + row) * 1024 + gsel * 256 + (tn & 1) * 128 + ch * 8) = pack8(v);
          else *(u32x4*)(p.P + ((long)tm * 256 + hf * 128 + row) * NP1 + tn * 128 + ch * 8) = pack8(v);
        }
      }
      __syncthreads();
    }
  }
}

DI void load64(const u16* src, float* v) {
#pragma unroll
  for (int q = 0; q < 8; q++) { u32x4 u = *(const u32x4*)(src + q * 8); unpack8(u, v + q * 8); }
}
DI void store64(u16* dst, const float* v) {
#pragma unroll
  for (int q = 0; q < 8; q++) *(u32x4*)(dst + q * 8) = pack8(v + q * 8);
}
DI void rope64(float* v, const float* T16, int row, int col) {
#pragma unroll
  for (int i = 0; i < 32; i++) {
    f32x2 cs = (i < 16) ? *(const f32x2*)(T16 + (row * 16 + i) * 2) : *(const f32x2*)(T16 + (col * 16 + (i - 16)) * 2);
    float t1 = v[i], t2 = v[i + 32];
    v[i] = t1 * cs.x - t2 * cs.y;
    v[i + 32] = t2 * cs.x + t1 * cs.y;
  }
}
DI void rope32(float* v, const float* T8, int row, int col) {
#pragma unroll
  for (int i = 0; i < 16; i++) {
    f32x2 cs = (i < 8) ? *(const f32x2*)(T8 + (row * 8 + i) * 2) : *(const f32x2*)(T8 + (col * 8 + (i - 8)) * 2);
    float t1 = v[i], t2 = v[i + 16];
    v[i] = t1 * cs.x - t2 * cs.y;
    v[i + 16] = t2 * cs.x + t1 * cs.y;
  }
}
DI void attn_prep_block(const Params& p, int l, int blk) {
  const int j = blk * 256 + otid();
  const int u = j / MH, mh = j % MH;
  const int bb = mh / T, t = mh % T;
  const bool lat = t >= 256;
  const int tl = t - 256, row = tl >> 6, col = tl & 63;
  const u16* prow = p.P + (long)mh * NP1;
  float v[64];
  if (u < 4) {
    load64(prow + C_QC + u * 64, v);
    float ss = 0.f;
#pragma unroll
    for (int i = 0; i < 64; i++) ss += v[i] * v[i];
    float rs = rsqrtf(ss * (1.f / 64.f) + 1e-6f);
    const float* g = p.in[21] + l * 64;
#pragma unroll
    for (int i = 0; i < 64; i++) v[i] = v[i] * rs * g[i];
    if (lat) rope64(v, p.rope16, row, col);
    const float sc = 0.125f * LOG2E;
#pragma unroll
    for (int i = 0; i < 64; i++) v[i] *= sc;
    store64(p.QC + ((long)(bb * 4 + u) * T + t) * 64, v);
  } else if (u < 6) {
    int hk = u - 4;
    load64(prow + C_KC + hk * 64, v);
    float ss = 0.f;
#pragma unroll
    for (int i = 0; i < 64; i++) ss += v[i] * v[i];
    float rs = rsqrtf(ss * (1.f / 64.f) + 1e-6f);
    const float* g = p.in[22] + l * 64;
#pragma unroll
    for (int i = 0; i < 64; i++) v[i] = v[i] * rs * g[i];
    if (lat) rope64(v, p.rope16, row, col);
    store64(p.KC + ((long)(bb * 2 + hk) * T + t) * 64, v);
  } else if (u < 8) {
    int hk = u - 6;
    const u16* s = prow + C_VC + hk * 64;
    u16* d = p.VCt + (long)(bb * 2 + hk) * 64 * T + t;
#pragma unroll
    for (int q = 0; q < 8; q++) {
      u32x4 w = *(const u32x4*)(s + q * 8);
      unsigned ww[4] = {w.x, w.y, w.z, w.w};
#pragma unroll
      for (int e = 0; e < 4; e++) {
        d[(long)(q * 8 + e * 2) * T] = (u16)(ww[e] & 0xffffu);
        d[(long)(q * 8 + e * 2 + 1) * T] = (u16)(ww[e] >> 16);
      }
    }
  } else if (u < 16) {
    bool isq = u < 12;
    int hd = isq ? u - 8 : u - 12;
    load64(prow + (isq ? C_QD : C_KD) + hd * 64, v);
    if (lat) { rope32(v, p.rope8, row, col); rope32(v + 32, p.rope8, row, col); }
    if (isq) {
      const float sc = 0.17677669529663687f * LOG2E;
#pragma unroll
      for (int i = 0; i < 64; i++) v[i] *= sc;
    }
    store64((isq ? p.QD : p.KD) + ((long)(bb * 4 + hd) * T + t) * 64, v);
  } else if (u < 20) {
    int hd = u - 16;
    const u16* s = prow + C_VD + hd * 64;
    u16* d = p.VDt + (long)(bb * 4 + hd) * 64 * T + t;
#pragma unroll
    for (int q = 0; q < 8; q++) {
      u32x4 w = *(const u32x4*)(s + q * 8);
      unsigned ww[4] = {w.x, w.y, w.z, w.w};
#pragma unroll
      for (int e = 0; e < 4; e++) {
        d[(long)(q * 8 + e * 2) * T] = (u16)(ww[e] & 0xffffu);
        d[(long)(q * 8 + e * 2 + 1) * T] = (u16)(ww[e] >> 16);
      }
    }
  } else {
#pragma unroll
    for (int q = 0; q < 4; q++) { u32x4 w = *(const u32x4*)(prow + C_KROPE + q * 8); unpack8(w, v + q * 8); }
    if (lat) rope32(v, p.rope8, row, col);
    u32x4 o4[4];
#pragma unroll
    for (int q = 0; q < 4; q++) o4[q] = pack8(v + q * 8);
#pragma unroll
    for (int hh = 0; hh < 4; hh++) {
      u16* d = p.KA + ((long)(bb * 4 + hh) * T + t) * 96 + 64;
#pragma unroll
      for (int q = 0; q < 4; q++) *(u32x4*)(d + q * 8) = o4[q];
    }
  }
}

DI void mla_up_tile(const Params& p, int l, int tm, int tn, char* smem) {
  u16* sA = (u16*)smem; u16* sW = sA + 128 * 72; float* sC = (float*)smem;
  float* sRs = (float*)(smem + 73728);
  const int tid = otid();
  const bool isq = tn < 3;
  const u16* Pt = p.P + (long)tm * 128 * NP1;
  {
    int row = tid >> 1, part = tid & 1;
    int n = isq ? 128 : 64;
    const u16* s = Pt + (long)row * NP1 + (isq ? C_QLAT : C_KVLAT) + part * n;
    float ss = 0.f;
    for (int q = 0; q < n / 8; q++) {
      u32x4 w = *(const u32x4*)(s + q * 8);
      float v[8]; unpack8(w, v);
#pragma unroll
      for (int e = 0; e < 8; e++) ss += v[e] * v[e];
    }
    ss += __int_as_float(__builtin_amdgcn_mov_dpp(__float_as_int(ss), 0xB1, 0xf, 0xf, true));
    if (part == 0) sRs[row] = rsqrtf(ss * (isq ? 1.f / 256.f : 1.f / 128.f) + 1e-6f);
  }
  f32x16 acc[2][2];
  zero_acc<2>(acc);
  if (isq) gemm_core<2>(acc, Pt + C_QLAT, NP1, p.Wt_uq + ((long)l * 384 + tn * 128) * 256, 256, 256, sA, sW);
  else     gemm_core<2>(acc, Pt + C_KVLAT, NP1, p.Wt_ukv + ((long)l * 512 + (tn - 3) * 128) * 128, 128, 128, sA, sW);
  dump_acc<2>(acc, sC);
  __syncthreads();
  const int bb = (tm * 128) / T, t0 = (tm * 128) % T;
  if (isq || tn < 5) {
    const float qs = 0.10206207261596577f * LOG2E;
#pragma unroll
    for (int ps = 0; ps < 8; ps++) {
      int row = (tid >> 4) + 16 * ps, ch = tid & 15, c0 = ch * 8;
      int t = t0 + row;
      float rs = sRs[row];
      const float* s = sC + row * CP;
      float v[8];
      if (isq && tn == 2) {
        int hh = c0 >> 5, i0 = c0 & 31;
        bool lat = t >= 256;
        int tl = t - 256, rw = tl >> 6, cl = tl & 63;
#pragma unroll
        for (int e = 0; e < 8; e++) {
          int i = i0 + e;
          float x = s[c0 + e];
          if (lat) {
            int ii = i & 15;
            f32x2 cs = (ii < 8) ? *(const f32x2*)(p.rope8 + (rw * 8 + ii) * 2) : *(const f32x2*)(p.rope8 + (cl * 8 + (ii - 8)) * 2);
            if (i < 16) { float t2 = s[c0 + e + 16]; x = x * cs.x - t2 * cs.y; }
            else        { float t1 = s[c0 + e - 16]; x = x * cs.x + t1 * cs.y; }
          }
          v[e] = x * rs * qs;
        }
        *(u32x4*)(p.QA + ((long)(bb * 4 + hh) * T + t) * 96 + 64 + i0) = pack8(v);
      } else {
        int f = (isq ? tn : tn - 3) * 128 + c0;
        int hh = f >> 6, d = f & 63;
        float scl = isq ? rs * qs : rs;
#pragma unroll
        for (int e = 0; e < 8; e++) v[e] = s[c0 + e] * scl;
        *(u32x4*)((isq ? p.QA : p.KA) + ((long)(bb * 4 + hh) * T + t) * 96 + d) = pack8(v);
      }
    }
  } else {
    int row = tid & 127, fh = tid >> 7;
    int t = t0 + row;
    float rs = sRs[row];
    int hh = (tn - 5) * 2 + fh;
    u16* d = p.VAt + (long)(bb * 4 + hh) * 64 * T + t;
    const float* s = sC + row * CP + fh * 64;
#pragma unroll 8
    for (int e = 0; e < 64; e++) d[(long)e * T] = f2bf(s[e] * rs);
  }
  __syncthreads();
}

DI void rwkv_prep_group(const Params& p, int l, int grp, char* smem) {
  u16* raw = (u16*)smem;
  float* lora = (float*)(smem + 10 * 1024 * 2);
  const int tid = otid();
  const int mh0 = grp * 8, bb = mh0 / T, t0 = mh0 % T;
  const int lo = t0 < 256 ? 0 : 256, hi = t0 < 256 ? 256 : T;
  __syncthreads();
#pragma unroll
  for (int i = 0; i < 5; i++) {
    int c = tid + i * 256;
    int rr = c >> 7, ch = c & 127;
    int t = t0 - 1 + rr;
    u32x4 w = u32x4{0, 0, 0, 0};
    if (t >= lo && t < hi) w = *(const u32x4*)(p.P + ((long)bb * T + t) * NP1 + C_SH + ch * 8);
    *(u32x4*)(raw + rr * 1024 + ch * 8) = w;
  }
  __syncthreads();
  const float* mup = p.in[11] + (long)l * 2 * 1024;
  const float* mun = mup + 1024;
  const float mp0 = mup[tid], mn0 = mun[tid], mp1 = mup[256 + tid], mn1 = mun[256 + tid];
  const float mp2 = mup[512 + tid], mn2 = mun[512 + tid], mp3 = mup[768 + tid], mn3 = mun[768 + tid];
#define SHIFTED(tt, c, MP, MN) ({ float x_ = bf2f(raw[((tt) + 1) * 1024 + (c)]); float xp_ = bf2f(raw[(tt) * 1024 + (c)]); \
                          float xn_ = bf2f(raw[((tt) + 2) * 1024 + (c)]); x_ + (MP) * (xp_ - x_) + (MN) * (xn_ - x_); })
  u16* Abf = (u16*)lora;
  float* zacc = (float*)(smem + 10 * 1024 * 2 + 32 * 264 * 2);
  {
    int c = 768 + tid;
#pragma unroll
    for (int tt = 0; tt < 8; tt++) {
      float s = SHIFTED(tt, c, mp3, mn3);
      if (tid < 128) s = tanhf(s);
      Abf[tt * 264 + tid] = f2bf(s);
    }
  }
  __syncthreads();
  {
    const int lane = tid & 63, wv = tid >> 6, r = lane & 31, h = lane >> 5;
    const u16* Wb = p.Wl + (long)l * 4 * 256 * 64;
#pragma unroll
    for (int m = 0; m < 4; m++) {
      f32x16 za[2];
#pragma unroll
      for (int ni = 0; ni < 2; ni++)
#pragma unroll
        for (int i = 0; i < 16; i++) za[ni][i] = 0.f;
#pragma unroll
      for (int ks = 0; ks < 4; ks++) {
        bf16x8 af_ = *(const bf16x8*)(Abf + r * 264 + m * 64 + ks * 16 + h * 8);
#pragma unroll
        for (int ni = 0; ni < 2; ni++) {
          bf16x8 bf_ = *(const bf16x8*)(Wb + ((long)m * 256 + wv * 64 + ni * 32 + r) * 64 + ks * 16 + h * 8);
          za[ni] = MFMA32(af_, bf_, za[ni]);
        }
      }
#pragma unroll
      for (int ni = 0; ni < 2; ni++)
#pragma unroll
        for (int i = 0; i < 4; i++) zacc[(m * 8 + i + 4 * h) * 256 + wv * 64 + ni * 32 + r] = za[ni][i];
    }
  }
  __syncthreads();
  const int c = tid;
  float zf[8], zb[8], af[8], ab[8];
#pragma unroll
  for (int tt = 0; tt < 8; tt++) {
    zf[tt] = zacc[(0 * 8 + tt) * 256 + c]; zb[tt] = zacc[(1 * 8 + tt) * 256 + c];
    af[tt] = zacc[(2 * 8 + tt) * 256 + c]; ab[tt] = zacc[(3 * 8 + tt) * 256 + c];
  }
  const float w0f = p.in[12][(l * 2 + 0) * 256 + c], w0b = p.in[12][(l * 2 + 1) * 256 + c];
  const float a0f = p.in[14][(l * 2 + 0) * 256 + c], a0b = p.in[14][(l * 2 + 1) * 256 + c];
  const float kkw = p.in[16][l * 256 + c], kaw = p.in[17][l * 256 + c], rkw = p.in[18][l * 256 + c];
  const int hd = c >> 6, cc = c & 63;
#pragma unroll
  for (int tt = 0; tt < 8; tt++) {
    int t = t0 + tt;
    float r = SHIFTED(tt, c, mp0, mn0), k = SHIFTED(tt, 256 + c, mp1, mn1), v = SHIFTED(tt, 512 + c, mp2, mn2);
    float wfv = __expf(-0.6065306597126334f * sigmoidf_(w0f + zf[tt]));
    float wbv = __expf(-0.6065306597126334f * sigmoidf_(w0b + zb[tt]));
    float afv = sigmoidf_(a0f + af[tt]), abv = sigmoidf_(a0b + ab[tt]);
    float kq = k * kkw;
    float ss = wave_sum(kq * kq);
    float kk = kq * rsqrtf(ss + 1e-12f);
    float kdf = k * (1.f + (afv - 1.f) * kaw), kdb = k * (1.f + (abv - 1.f) * kaw);
    float bs = wave_sum(r * (kdf + kdb) * rkw);
    u16* si = p.SI + (((long)(bb * 4 + hd) * T + t) * 9) * 64 + cc;
    _Float16 hv;
#define PUTH(idx, val) hv = (_Float16)(val); si[(idx) * 64] = __builtin_bit_cast(u16, hv);
    PUTH(0, r) PUTH(1, kk) PUTH(2, v) PUTH(3, wfv) PUTH(4, kdf) PUTH(5, kk * afv) PUTH(6, wbv) PUTH(7, kdb) PUTH(8, kk * abv)
#undef PUTH
    p.bonus[((long)bb * T + t) * 256 + c] = bs * v;
  }
#undef SHIFTED
  __syncthreads();
}

DI void phase_prep(const Params& p, int l, int half, char* smem) {
  const int n_rw = MH / 8, n_mla = 136 * 7, n_ap = 21 * (MH / 256);
  const int total = n_rw + n_mla + n_ap;
  for (int it = blockIdx.x; it < total; it += gridDim.x) {
    if (it < n_rw) rwkv_prep_group(p, l, it, smem);
    else if (it < n_rw + n_mla) { int q = it - n_rw; mla_up_tile(p, l, q / 7, q % 7, smem); }
    else attn_prep_block(p, l, it - n_rw - n_mla);
  }
}

template <int TYPE>
DI void attn_item(const Params& p, int l, int bb, int head, int qb, char* smem) {
  constexpr int DK = (TYPE == 0) ? 96 : 64;
  constexpr int KP = DK + 8;
  constexpr int NKS = (TYPE == 0) ? 6 : (TYPE == 1 ? 4 : 2);
  constexpr int NMAP = (TYPE == 2) ? 2 : 1;
  constexpr int KCH = DK / 8;
  constexpr int NKL = (64 * KCH) / 256;
  u16* sK = (u16*)smem;
  u16* sV = sK + 64 * KP;
  const int tid = otid(), lane = tid & 63, wv = tid >> 6, r = lane & 31, h = lane >> 5;
  const int qt0 = qb * 128;
  const int nkeys = (qb < 2) ? 256 : T;
  const u16 *Kg, *Vg, *Qg;
  if (TYPE == 0) { Kg = p.KA + (long)(bb * 4 + head) * T * 96; Vg = p.VAt + (long)(bb * 4 + head) * 64 * T; Qg = p.QA + ((long)(bb * 4 + head) * T + qt0 + wv * 32 + r) * 96; }
  else if (TYPE == 1) { Kg = p.KC + (long)(bb * 2 + (head >> 1)) * T * 64; Vg = p.VCt + (long)(bb * 2 + (head >> 1)) * 64 * T; Qg = p.QC + ((long)(bb * 4 + head) * T + qt0 + wv * 32 + r) * 64; }
  else { Kg = p.KD + (long)(bb * 4 + head) * T * 64; Vg = p.VDt + (long)(bb * 4 + head) * 64 * T; Qg = p.QD + ((long)(bb * 4 + head) * T + qt0 + wv * 32 + r) * 64; }
  bf16x8 qf[NMAP][NKS];
#pragma unroll
  for (int mp = 0; mp < NMAP; mp++)
#pragma unroll
    for (int ks = 0; ks < NKS; ks++) qf[mp][ks] = *(const bf16x8*)(Qg + mp * 32 + ks * 16 + h * 8);
  f32x16 O[NMAP][2];
  float mrun[NMAP], lrun[NMAP];
  f32x16 nm;
#pragma unroll
  for (int i = 0; i < 16; i++) nm[i] = 0.f;
#pragma unroll
  for (int mp = 0; mp < NMAP; mp++) {
    mrun[mp] = (TYPE == 2) ? -1e30f : 0.f; lrun[mp] = 0.f;
#pragma unroll
    for (int d = 0; d < 2; d++)
#pragma unroll
      for (int i = 0; i < 16; i++) O[mp][d][i] = 0.f;
  }
  u32x4 rk[NKL], rv[2];
  auto gload = [&](int key0) {
#pragma unroll
    for (int i = 0; i < NKL; i++) { int c = tid + i * 256; int row = c / KCH, cc = c % KCH; rk[i] = *(const u32x4*)(Kg + (long)(key0 + row) * DK + cc * 8); }
#pragma unroll
    for (int i = 0; i < 2; i++) { int c = tid + i * 256; int row = c >> 3, cc = c & 7; rv[i] = *(const u32x4*)(Vg + (long)row * T + key0 + cc * 8); }
  };
  gload(0);
  const int ntile = nkeys >> 6;
  __syncthreads();
  for (int kt = 0; kt < ntile; kt++) {
#pragma unroll
    for (int i = 0; i < NKL; i++) { int c = tid + i * 256; int row = c / KCH, cc = c % KCH; *(u32x4*)(sK + row * KP + cc * 8) = rk[i]; }
#pragma unroll
    for (int i = 0; i < 2; i++) { int c = tid + i * 256; int row = c >> 3, cc = c & 7; *(u32x4*)(sV + row * 72 + cc * 8) = rv[i]; }
    __syncthreads();
    if (kt + 1 < ntile) gload((kt + 1) * 64);
#pragma unroll
    for (int mp = 0; mp < NMAP; mp++) {
      f32x16 s[2];
#pragma unroll
      for (int kb = 0; kb < 2; kb++) {
#pragma unroll
        for (int ks = 0; ks < NKS; ks++) {
          bf16x8 kf = *(const bf16x8*)(sK + (kb * 32 + r) * KP + mp * 32 + ks * 16 + h * 8);
          if (ks == 0) {
            if (TYPE == 2) { f32x16 z; for (int i = 0; i < 16; i++) z[i] = 0.f; s[kb] = MFMA32(kf, qf[mp][ks], z); }
            else s[kb] = MFMA32(kf, qf[mp][ks], nm);
          } else s[kb] = MFMA32(kf, qf[mp][ks], s[kb]);
        }
      }
      float mx = s[0][0];
#pragma unroll
      for (int i = 1; i < 16; i++) mx = fmaxf(mx, s[0][i]);
#pragma unroll
      for (int i = 0; i < 16; i++) mx = fmaxf(mx, s[1][i]);
      mx = xmax32(mx);
      float psum = 0.f;
      if (TYPE == 2) {
        if (__builtin_amdgcn_ballot_w64(mx > mrun[mp]) != 0ull) {
          float mnew = fmaxf(mrun[mp], mx);
          float alpha = __builtin_amdgcn_exp2f(mrun[mp] - mnew);
          mrun[mp] = mnew;
          lrun[mp] *= alpha;
#pragma unroll
          for (int d = 0; d < 2; d++)
#pragma unroll
            for (int i = 0; i < 16; i++) O[mp][d][i] *= alpha;
        }
        const float mcur = mrun[mp];
#pragma unroll
        for (int kb = 0; kb < 2; kb++)
#pragma unroll
          for (int i = 0; i < 16; i++) { float e = __builtin_amdgcn_exp2f(s[kb][i] - mcur); s[kb][i] = e; psum += e; }
      } else {
        if (__builtin_amdgcn_ballot_w64(mx > 0.f) != 0ull) {
          float delta = fmaxf(mx, 0.f);
          float alpha = __builtin_amdgcn_exp2f(-delta);
          mrun[mp] += delta;
          lrun[mp] *= alpha;
#pragma unroll
          for (int d = 0; d < 2; d++)
#pragma unroll
            for (int i = 0; i < 16; i++) O[mp][d][i] *= alpha;
#pragma unroll
          for (int kb = 0; kb < 2; kb++)
#pragma unroll
            for (int i = 0; i < 16; i++) s[kb][i] -= delta;
          const float nmv = -mrun[mp];
#pragma unroll
          for (int i = 0; i < 16; i++) nm[i] = nmv;
        }
#pragma unroll
        for (int kb = 0; kb < 2; kb++)
#pragma unroll
          for (int i = 0; i < 16; i++) { float e = __builtin_amdgcn_exp2f(s[kb][i]); s[kb][i] = e; psum += e; }
      }
      lrun[mp] += psum;
#pragma unroll
      for (int kb = 0; kb < 2; kb++)
#pragma unroll
        for (int s2 = 0; s2 < 2; s2++) {
          unsigned pw[4];
#pragma unroll
          for (int e = 0; e < 4; e++) pw[e] = pack2(s[kb][8 * s2 + 2 * e], s[kb][8 * s2 + 2 * e + 1]);
          u32x4 pu = u32x4{pw[0], pw[1], pw[2], pw[3]};
          bf16x8 pf = __builtin_bit_cast(bf16x8, pu);
#pragma unroll
          for (int d = 0; d < 2; d++) {
            const u16* vp = sV + (d * 32 + r) * 72 + kb * 32 + s2 * 16 + 4 * h;
            s16x4 vlo = *(const s16x4*)vp, vhi = *(const s16x4*)(vp + 8);
            bf16x8 vf = __builtin_shufflevector(vlo, vhi, 0, 1, 2, 3, 4, 5, 6, 7);
            O[mp][d] = MFMA32(vf, pf, O[mp][d]);
          }
        }
    }
    __syncthreads();
  }
  float inv[NMAP];
#pragma unroll
  for (int mp = 0; mp < NMAP; mp++) { float lt = xsum32(lrun[mp]); inv[mp] = 1.f / lt; }
  const int tid2 = otid();
  const int r2 = tid2 & 31, h2 = (tid2 >> 5) & 1, wv2 = tid2 >> 6;
  const int t = qb * 128 + wv2 * 32 + r2;
  const long mh = (long)bb * T + t;
  const int gcol = (TYPE == 0) ? 0 : (TYPE == 1 ? 512 : 768);
  const int ocol = (TYPE == 0) ? 0 : (TYPE == 1 ? 512 : 768);
  float val[2][16];
  if (TYPE == 2) {
    float lam = p.lam[l], li = p.lam[2 + l];
    float ss = 0.f;
#pragma unroll
    for (int d = 0; d < 2; d++)
#pragma unroll
      for (int i = 0; i < 16; i++) { float x = O[0][d][i] * inv[0] - lam * O[NMAP - 1][d][i] * inv[NMAP - 1]; val[d][i] = x; ss += x * x; }
    ss = xsum32(ss);
    float rs = rsqrtf(ss * (1.f / 64.f) + 1e-5f) * (1.f - li);
    const float* sg = p.in[24] + l * 64;
#pragma unroll
    for (int d = 0; d < 2; d++)
#pragma unroll
      for (int i = 0; i < 16; i++) { int dv = d * 32 + (i & 3) + 8 * (i >> 2) + 4 * h2; val[d][i] *= rs * sg[dv]; }
  } else {
#pragma unroll
    for (int d = 0; d < 2; d++)
#pragma unroll
      for (int i = 0; i < 16; i++) val[d][i] = O[0][d][i] * inv[0];
  }
#pragma unroll
  for (int d = 0; d < 2; d++)
#pragma unroll
    for (int g = 0; g < 4; g++) {
      int dv0 = d * 32 + 8 * g + 4 * h2;
      u32x2 gw = *(const u32x2*)(p.Gs + mh * 1024 + gcol + head * 64 + dv0);
      float g0 = lo_bf(gw.x), g1 = hi_bf(gw.x), g2 = lo_bf(gw.y), g3 = hi_bf(gw.y);
      u32x2 ow;
      ow.x = pack2(val[d][4 * g] * siluf_(g0), val[d][4 * g + 1] * siluf_(g1));
      ow.y = pack2(val[d][4 * g + 2] * siluf_(g2), val[d][4 * g + 3] * siluf_(g3));
      *(u32x2*)(p.o + mh * DM + ocol + head * 64 + dv0) = ow;
    }
}

DI void scan_item(const Params& p, int item, char* smem) {
  float* sIn = (float*)smem;
  float* sY = (float*)(smem + 2 * 16 * 6 * 64 * 4);
  const int tid = otid(), lane = tid & 63, wv = tid >> 6;
  const int bb = item >> 5, hd = (item >> 3) & 3, dir = (item >> 2) & 1, rg = item & 3;
  const int rowl = wv * 4 + (lane >> 4), cg4 = (lane & 15) * 4;
  const u16* SIb = p.SI + ((long)(bb * 4 + hd) * T) * 9 * 64;
  u16* yb = p.yscan + ((long)dir * MH + (long)bb * T) * 256 + hd * 64 + rg * 16;
  auto tof = [&](int s) { return dir == 0 ? s : (s < 256 ? 255 - s : 4607 - s); };
  u32x4 rg_[3];
  auto gload = [&](int ci) {
#pragma unroll
    for (int i = 0; i < 3; i++) {
      int id = tid + i * 256;
      int st = id / 48, rem = id % 48, vec = rem >> 3, part = rem & 7;
      int t = tof(ci * 16 + st);
      int vi = vec < 3 ? vec : vec + 3 * dir;
      rg_[i] = *(const u32x4*)(SIb + ((long)t * 9 + vi) * 64 + part * 8);
    }
  };
  auto lstore = [&](int buf) {
#pragma unroll
    for (int i = 0; i < 3; i++) {
      int id = tid + i * 256;
      int st = id / 48, rem = id % 48, vec = rem >> 3, part = rem & 7;
      h8 hv = __builtin_bit_cast(h8, rg_[i]);
      f8 fv = __builtin_convertvector(hv, f8);
      float* d = sIn + ((buf * 16 + st) * 6 + vec) * 64 + part * 8;
      *(f32x4v*)d = f32x4v{fv[0], fv[1], fv[2], fv[3]};
      *(f32x4v*)(d + 4) = f32x4v{fv[4], fv[5], fv[6], fv[7]};
    }
  };
  f32x2 Sa = {0.f, 0.f}, Sb = {0.f, 0.f};
  __syncthreads();
  gload(0);
  lstore(0);
  __syncthreads();
  __builtin_amdgcn_s_setprio(3);
  const int nch = T / 16;
  const int voff = 128 + rg * 16 + rowl;
  const int l16 = lane & 15;
  struct StepIn { f32x4v r, k, w, d, b; float v; };
  auto ldstep = [&](const float* b) {
    StepIn x;
    x.r = *(const f32x4v*)(b + cg4); x.k = *(const f32x4v*)(b + 64 + cg4); x.v = b[voff];
    x.w = *(const f32x4v*)(b + 192 + cg4); x.d = *(const f32x4v*)(b + 256 + cg4); x.b = *(const f32x4v*)(b + 320 + cg4);
    return x;
  };
  for (int ci = 0; ci < nch; ci++) {
    if (ci + 1 < nch) gload(ci + 1);
    const float* base = sIn + (ci & 1) * 16 * 6 * 64;
    float ykeep = 0.f;
    StepIn cur = ldstep(base);
#pragma unroll
    for (int st = 0; st < 16; st++) {
      StepIn nxt = cur;
      if (st + 1 < 16) nxt = ldstep(base + (st + 1) * 6 * 64);
      __builtin_amdgcn_sched_barrier(0);
      f32x2 ra = {cur.r.x, cur.r.y}, rb = {cur.r.z, cur.r.w}, ka = {cur.k.x, cur.k.y}, kb = {cur.k.z, cur.k.w};
      f32x2 wa = {cur.w.x, cur.w.y}, wb = {cur.w.z, cur.w.w}, da = {cur.d.x, cur.d.y}, db = {cur.d.z, cur.d.w};
      f32x2 ba = {cur.b.x, cur.b.y}, bb2 = {cur.b.z, cur.b.w};
      f32x2 pp = Sa * ka + Sb * kb;
      float sa = allreduce16(pp.x + pp.y);
      f32x2 vv2 = {cur.v, cur.v};
      f32x2 sa2 = {sa, sa};
      Sa = (Sa * wa + vv2 * da) - sa2 * ba;
      Sb = (Sb * wb + vv2 * db) - sa2 * bb2;
      f32x2 yy = Sa * ra + Sb * rb;
      float y = allreduce16(yy.x + yy.y);
      ykeep = (l16 == st) ? y : ykeep;
      cur = nxt;
    }
    { _Float16 yh = (_Float16)ykeep; yb[(long)tof(ci * 16 + l16) * 256 + rowl] = __builtin_bit_cast(u16, yh); }
    if (ci + 1 < nch) lstore((ci + 1) & 1);
    __syncthreads();
  }
  __builtin_amdgcn_s_setprio(0);
}

DI void gates_tile(const Params& p, int l, int half, int it, char* smem) {
  u16* sA = (u16*)smem; u16* sW = sA + 256 * 72; float* sC = (float*)smem;
  const int tid = otid();
  int tm = it >> 5, tn = it & 31;
  long row0 = (l == 0) ? (long)tm * 256 : (long)(tm >> 4) * T + 256 + (tm & 15) * 256;
  f32x16 acc[4][2];
#pragma unroll
  for (int a = 0; a < 4; a++)
#pragma unroll
    for (int b = 0; b < 2; b++)
#pragma unroll
      for (int i = 0; i < 16; i++) acc[a][b][i] = 0.f;
  __syncthreads();
  gemm_core256(acc, p.A + ((long)half * MH + row0) * DM, DM, p.Wt_in + ((long)l * NPAD + C_MG + tn * 128) * 1024, 1024, 1024, sA, sW);
  const float* mb = p.in[25] + l * 4096 + tn * 128;
#pragma unroll
  for (int hf = 0; hf < 2; hf++) {
    dump_acc256(acc, sC, hf);
    __syncthreads();
#pragma unroll
    for (int ps = 0; ps < 8; ps++) {
      int row = (tid >> 4) + 16 * ps, ch = tid & 15;
      const float* s = sC + row * CP + ch * 8;
      f32x4v a = *(const f32x4v*)s, b = *(const f32x4v*)(s + 4);
      f32x4v m0 = *(const f32x4v*)(mb + ch * 8), m1 = *(const f32x4v*)(mb + ch * 8 + 4);
      float v[8];
      v[0] = sigmoidf_(a.x + m0.x); v[1] = sigmoidf_(a.y + m0.y); v[2] = sigmoidf_(a.z + m0.z); v[3] = sigmoidf_(a.w + m0.w);
      v[4] = sigmoidf_(b.x + m1.x); v[5] = sigmoidf_(b.y + m1.y); v[6] = sigmoidf_(b.z + m1.z); v[7] = sigmoidf_(b.w + m1.w);
      *(u32x4*)(p.G + (row0 + hf * 128 + row) * 4096 + tn * 128 + ch * 8) = pack8(v);
    }
    __syncthreads();
  }
}

DI void phase_attn_scan(const Params& p, int l, int half, char* smem, int rep) {
  __shared__ int s_item;
  const int n_scan = 128, n_lat = 3 * 512, n_ctx = (l == 0) ? 96 : 0;
  const int n_gate = ((l == 0) ? 68 : 64) * 32;
  const int n_conv = (l == 0 && half == 0) ? 128 : 0;
  const int total = n_scan + n_conv + n_lat + n_ctx + n_gate;
  unsigned* cnt = p.cnt + (l * 2 + half) + 8 * rep;
  for (;;) {
    __syncthreads();
    if (threadIdx.x == 0) s_item = (int)atomicAdd(cnt, 1u);
    __syncthreads();
    int it = s_item;
    if (it >= total) break;
    if (it < n_scan) { scan_item(p, it, smem); continue; }
    it -= n_scan;
    if (it < n_conv) { conv_layer(p, 1, (long)it * 256 + otid(), (long)n_conv * 256); continue; }
    it -= n_conv;
    int type, bb, head, qb;
    if (it < n_lat) {
      int ty = it / 512, q = it % 512;
      type = (ty == 0) ? 2 : (ty == 1 ? 0 : 1);
      qb = 2 + (q & 31); head = (q >> 5) & 3; bb = q >> 7;
    } else if (it >= n_lat + n_ctx) {
      gates_tile(p, l, half, it - n_lat - n_ctx, smem);
      continue;
    } else {
      it -= n_lat;
      int ty = it / 32, q = it % 32;
      type = (ty == 0) ? 2 : (ty == 1 ? 0 : 1);
      qb = q & 1; head = (q >> 1) & 3; bb = q >> 3;
    }
    if (type == 0) attn_item<0>(p, l, bb, head, qb, smem);
    else if (type == 1) attn_item<1>(p, l, bb, head, qb, smem);
    else attn_item<2>(p, l, bb, head, qb, smem);
  }
}

DI void phase_rwkv_post(const Params& p, int l, int half) {
  const int c = otid();
  const float gw = p.in[19][l * 256 + c], gb = p.in[20][l * 256 + c];
  for (int m0 = blockIdx.x * 4; m0 < MH; m0 += gridDim.x * 4) {
    float y[4], bo[4], g[4];
#pragma unroll
    for (int q = 0; q < 4; q++) {
      long mh = m0 + q;
      y[q] = (float)__builtin_bit_cast(_Float16, p.yscan[mh * 256 + c]) + (float)__builtin_bit_cast(_Float16, p.yscan[((long)MH + mh) * 256 + c]);
      bo[q] = p.bonus[mh * 256 + c];
      g[q] = bf2f(p.Gs[mh * 1024 + 256 + c]);
    }
    float mu[4], d[4], var[4];
#pragma unroll
    for (int q = 0; q < 4; q++) mu[q] = wave_sum(y[q]) * (1.f / 64.f);
#pragma unroll
    for (int q = 0; q < 4; q++) { d[q] = y[q] - mu[q]; var[q] = wave_sum(d[q] * d[q]) * (1.f / 64.f); }
#pragma unroll
    for (int q = 0; q < 4; q++) {
      long mh = m0 + q;
      float ob = d[q] * rsqrtf(var[q] + 64e-5f) * gw + gb + bo[q];
      p.o[mh * DM + 256 + c] = f2bf(ob * siluf_(g[q]));
    }
  }
}

DI void phase_merge(const Params& p, int l, int half, char* smem) {
  u16* sA = (u16*)smem; u16* sW = sA + 128 * 72; float* sC = (float*)smem;
  const int tid = otid();
  const int nq = (l == 0) ? 34 : 32;
  const int ntiles = 4 * nq * 8;
  for (int it = blockIdx.x; it < ntiles; it += gridDim.x) {
    int tmi = it >> 3, tn = it & 7;
    int bb = tmi / nq, qb = tmi % nq + (34 - nq);
    long mh0 = (long)bb * T + qb * 128;
    float y[8][8];
#pragma unroll
    for (int a = 0; a < 8; a++)
#pragma unroll
      for (int b = 0; b < 8; b++) y[a][b] = 0.f;
#pragma unroll 1
    for (int i = 0; i < 4; i++) {
      f32x16 acc[2][2];
      zero_acc<2>(acc);
      gemm_core<2>(acc, p.o + mh0 * DM + i * 256, DM, p.Wt_br + (((long)l * 4 + i) * 1024 + tn * 128) * 256, 256, 256, sA, sW);
      dump_acc<2>(acc, sC);
      __syncthreads();
#pragma unroll
      for (int ps = 0; ps < 8; ps++) {
        int row = (tid >> 4) + 16 * ps, ch = tid & 15;
        const float* s = sC + row * CP + ch * 8;
        f32x4v a = *(const f32x4v*)s, b = *(const f32x4v*)(s + 4);
        u32x4 g = *(const u32x4*)(p.G + (mh0 + row) * 4096 + i * 1024 + tn * 128 + ch * 8);
        y[ps][0] += lo_bf(g.x) * a.x; y[ps][1] += hi_bf(g.x) * a.y; y[ps][2] += lo_bf(g.y) * a.z; y[ps][3] += hi_bf(g.y) * a.w;
        y[ps][4] += lo_bf(g.z) * b.x; y[ps][5] += hi_bf(g.z) * b.y; y[ps][6] += lo_bf(g.w) * b.z; y[ps][7] += hi_bf(g.w) * b.w;
      }
      __syncthreads();
    }
#pragma unroll
    for (int ps = 0; ps < 8; ps++) {
      int row = (tid >> 4) + 16 * ps, ch = tid & 15;
      *(u32x4*)(p.ybuf + (mh0 + row) * DM + tn * 128 + ch * 8) = pack8(y[ps]);
    }
  }
}

DI void phase_outproj(const Params& p, int l, int half, char* smem) {
  u16* sA = (u16*)smem; u16* sW = sA + 128 * 72; float* sC = (float*)smem;
  const int tid = otid();
  const int nq = (l == 0) ? 34 : 32;
  const int ntiles = 4 * nq * 8;
  for (int it = blockIdx.x; it < ntiles; it += gridDim.x) {
    int tmi = it >> 3, tn = it & 7;
    int bb = tmi / nq, qb = tmi % nq + (34 - nq);
    long mh0 = (long)bb * T + qb * 128;
    int b = half * HB + bb;
    f32x16 acc[2][2];
    zero_acc<2>(acc);
    gemm_core<2>(acc, p.ybuf + mh0 * DM, DM, p.Wt_out + ((long)l * 1024 + tn * 128) * 1024, 1024, 1024, sA, sW);
    dump_acc<2>(acc, sC);
    __syncthreads();
    const float* gate = p.mod + ((long)l * 9 + (qb < 2 ? 8 : b)) * 3072 + 2048 + tn * 128;
#pragma unroll
    for (int ps = 0; ps < 8; ps++) {
      int row = (tid >> 4) + 16 * ps, ch = tid & 15;
      int t = qb * 128 + row;
      const float* s = sC + row * CP + ch * 8;
      const float* xr = xrow(p, l, b, t) + tn * 128 + ch * 8;
      float* hd = p.hbuf + (mh0 + row) * DM + tn * 128 + ch * 8;
#pragma unroll
      for (int q = 0; q < 2; q++) {
        f32x4v z = *(const f32x4v*)(s + q * 4), x4 = *(const f32x4v*)(xr + q * 4), g4 = *(const f32x4v*)(gate + ch * 8 + q * 4);
        f32x4v o4 = f32x4v{ALPHA_DN * x4.x + g4.x * z.x, ALPHA_DN * x4.y + g4.y * z.y, ALPHA_DN * x4.z + g4.z * z.z, ALPHA_DN * x4.w + g4.w * z.w};
        *(f32x4v*)(hd + q * 4) = o4;
      }
    }
    __syncthreads();
  }
}


#define XB_TMO      128
#define XB_XCNT(j)  (256  + 64 * (j))
#define XB_XSUB(j)  (1280 + 64 * (j))
#define XB_XGEN(j)  (2304 + 64 * (j))
#define XB_TOP      3328
#define XB_TOPGEN   3392
#define XCD_BAR_WORDS 3456
#define XB_SPIN_CAP (1u << 20)
#define LAS __attribute__((address_space(3)))
DI unsigned xb_ld(unsigned* p) { return __hip_atomic_load(p, __ATOMIC_RELAXED, __HIP_MEMORY_SCOPE_AGENT); }
DI unsigned xb_add(unsigned* p, unsigned v) { return __hip_atomic_fetch_add(p, v, __ATOMIC_RELAXED, __HIP_MEMORY_SCOPE_AGENT); }
DI unsigned xb_xcc_id() { return (unsigned)__builtin_amdgcn_s_getreg((3 << 11) | 20) & 0xFu; }
#define XB_SPIN(cond, bar) do { unsigned _sp = 0; while (cond) { __builtin_amdgcn_s_sleep(1); \
    if ((++_sp & 255u) == 0u) { if (xb_ld(&(bar)[XB_TMO])) break; if (_sp > XB_SPIN_CAP) { atomicAdd(&(bar)[XB_TMO], 1u); break; } } } } while (0)
struct XcdBarrier { unsigned* bar; unsigned x; volatile LAS unsigned* st; };
DI XcdBarrier xcd_barrier_post(unsigned* bar, volatile LAS unsigned* st) {
  XcdBarrier b; b.bar = bar; b.x = xb_xcc_id(); b.st = st;
  if (threadIdx.x == 0) (void)xb_add(&bar[XB_XCNT(b.x)], 1u);
  return b;
}
DI void xcd_barrier_complete(unsigned* bar, unsigned x, unsigned& nloc, unsigned& nx) {
  const unsigned G = gridDim.x * gridDim.y * gridDim.z;
  unsigned sum, cnt, mine, sp = 0u;
  for (;;) {
    sum = 0u; cnt = 0u; mine = 0u;
#pragma unroll
    for (unsigned j = 0; j < 16; ++j) { const unsigned c = xb_ld(&bar[XB_XCNT(j)]); sum += c; cnt += (c > 0u) ? 1u : 0u; mine = (j == x) ? c : mine; }
    if (sum == G) break;
    __builtin_amdgcn_s_sleep(1);
    if ((++sp & 255u) == 0u) { if (xb_ld(&bar[XB_TMO])) break; if (sp > XB_SPIN_CAP) { atomicAdd(&bar[XB_TMO], 1u); break; } }
  }
  nloc = mine > 0u ? mine : 1u; nx = cnt > 0u ? cnt : 1u;
}
DI void xcd_barrier(const XcdBarrier& b) {
  asm volatile("s_waitcnt vmcnt(0)" ::: "memory");
  __syncthreads();
  if (threadIdx.x == 0) {
    unsigned* bar = b.bar;
    __builtin_amdgcn_s_waitcnt(0);
    unsigned nloc = b.st[0], nx = b.st[1];
    if (nloc == 0u) { xcd_barrier_complete(bar, b.x, nloc, nx); b.st[0] = nloc; b.st[1] = nx; }
    const unsigned old = xb_add(&bar[XB_XSUB(b.x)], 1u);
    const unsigned gen = old / nloc;
    if (old + 1u == (gen + 1u) * nloc) {
      __builtin_amdgcn_fence(__ATOMIC_RELEASE, "agent");
      asm volatile("s_waitcnt vmcnt(0)" ::: "memory");
      const unsigned og = xb_add(&bar[XB_TOP], 1u);
      const unsigned tg = og / nx;
      if (og + 1u == (tg + 1u) * nx) xb_add(&bar[XB_TOPGEN], 1u);
      else XB_SPIN(xb_ld(&bar[XB_TOPGEN]) == tg, bar);
      __builtin_amdgcn_fence(__ATOMIC_ACQUIRE, "agent");
      xb_add(&bar[XB_XGEN(b.x)], 1u);
      asm volatile("s_waitcnt vmcnt(0)" ::: "memory");
    } else {
      XB_SPIN(xb_ld(&bar[XB_XGEN(b.x)]) == gen, bar);
      __builtin_amdgcn_fence(__ATOMIC_ACQUIRE, "agent");
      asm volatile("s_waitcnt vmcnt(0)" ::: "memory");
    }
  }
  __syncthreads();
}

constexpr int NSTEPS = 2 + 2 * 2 * (7 + (REPEAT_PH >= 0 ? 1 : 0));
DI void run_step(const Params& p, int s, char* smem) {
  if (s == 0) { phase_prologue(p, smem); return; }
  if (s == 1) { phase_rows(p, 0, 0); return; }
  int q = s - 2;
  constexpr int PER = 7 + (REPEAT_PH >= 0 ? 1 : 0);
  int l = q / (2 * PER), half = (q / PER) % 2, idx = q % PER;
  int ph = (REPEAT_PH >= 0 && idx > REPEAT_PH) ? idx - 1 : idx;
  int rep = (REPEAT_PH >= 0 && idx == REPEAT_PH + 1) ? 1 : 0;
  switch (ph) {
    case 0: phase_inproj(p, l, half, smem); break;
    case 1: phase_prep(p, l, half, smem); break;
    case 2: phase_attn_scan(p, l, half, smem, rep); break;
    case 3: phase_rwkv_post(p, l, half); break;
    case 4: phase_merge(p, l, half, smem); break;
    case 5: phase_outproj(p, l, half, smem); break;
    default: phase_rows(p, l + 1, half); break;
  }
}

__global__ void __launch_bounds__(256, 2) mega(Params p, int s_lo, int s_hi) {
  __shared__ __attribute__((aligned(16))) char smem[SMEM_BYTES];
  __shared__ u32x4 xb_words;
  if (threadIdx.x == 0) xb_words = u32x4{0u, 0u, 0u, 0u};
  __syncthreads();
  XcdBarrier xb = xcd_barrier_post(p.bar, (volatile LAS unsigned*)&xb_words);
  if (s_hi < 0) cg::this_grid().sync();
  for (int s = s_lo; s < s_hi; s++) {
    run_step(p, s, smem);
    if (s + 1 < s_hi) xcd_barrier(xb);
  }
}

extern "C" void kernel_launch(void* const* d_in, const int* in_sizes, int n_in, void* d_out, int out_size,
                              void* d_ws, size_t ws_size, hipStream_t stream) {
  static int grid_blocks = 0;
  if (!grid_blocks) {
    int dev = 0, cus = 0, per_cu = 0;
    (void)hipGetDevice(&dev);
    (void)hipDeviceGetAttribute(&cus, hipDeviceAttributeMultiprocessorCount, dev);
    (void)hipOccupancyMaxActiveBlocksPerMultiprocessor(&per_cu, mega, 256, 0);
    if (per_cu > 2) per_cu = 2;
    if (per_cu < 1) per_cu = 1;
    grid_blocks = cus * per_cu;
  }
  Params p{};
  for (int i = 0; i < 30; i++) p.in[i] = (const float*)d_in[i];
  p.out = (float*)d_out;
  char* w = (char*)d_ws;
  size_t off = 0;
  auto take = [&](size_t bytes) { char* r = w + off; off += (bytes + 255) & ~(size_t)255; return r; };
  p.Wt_in = (u16*)take((size_t)2 * NPAD * 1024 * 2);
  p.Wt_uq = (u16*)take((size_t)2 * 384 * 256 * 2);
  p.Wt_ukv = (u16*)take((size_t)2 * 512 * 128 * 2);
  p.Wt_br = (u16*)take((size_t)2 * 4 * 1024 * 256 * 2);
  p.Wt_out = (u16*)take((size_t)2 * 1024 * 1024 * 2);
  p.Wl = (u16*)take((size_t)2 * 4 * 256 * 64 * 2);
  p.mod = (float*)take((size_t)2 * 9 * 3072 * 4);
  p.rope16 = (float*)take(64 * 16 * 2 * 4);
  p.rope8 = (float*)take(64 * 8 * 2 * 4);
  p.lam = (float*)take(256);
  p.cnt = (unsigned*)take(256);
  p.bar = (unsigned*)take(XCD_BAR_WORDS * 4);
  p.A = (u16*)take((size_t)MT * DM * 2);
  p.ctx1 = (float*)take((size_t)NB * 256 * DM * 4);
  p.P = (u16*)take((size_t)MH * 4096 * 2);
  p.QA = (u16*)take((size_t)HB * 4 * T * 96 * 2);
  p.KA = (u16*)take((size_t)HB * 4 * T * 96 * 2);
  p.VAt = (u16*)take((size_t)HB * 4 * 64 * T * 2);
  p.QC = (u16*)take((size_t)HB * 4 * T * 64 * 2);
  p.KC = (u16*)take((size_t)HB * 2 * T * 64 * 2);
  p.VCt = (u16*)take((size_t)HB * 2 * 64 * T * 2);
  p.QD = (u16*)take((size_t)HB * 4 * T * 64 * 2);
  p.KD = (u16*)take((size_t)HB * 4 * T * 64 * 2);
  p.VDt = (u16*)take((size_t)HB * 4 * 64 * T * 2);
  p.SI = (u16*)take((size_t)HB * 4 * T * 9 * 64 * 2);
  p.bonus = (float*)take((size_t)MH * 256 * 4);
  p.yscan = (u16*)take((size_t)2 * MH * 256 * 2);
  p.Gs = (u16*)take((size_t)MH * 1024 * 2);
  p.o = (u16*)take((size_t)MH * DM * 2);
  p.G = p.P;
  p.ybuf = p.SI;
  p.hbuf = (float*)p.QA;
  if (off > ws_size) fprintf(stderr, "workspace too small: need %zu have %zu\n", off, ws_size);
  (void)hipMemsetAsync(p.cnt, 0, 256 + ((XCD_BAR_WORDS * 4 + 255) & ~255), stream);
#if MULTI_LAUNCH
  for (int s = 0; s < NSTEPS; s++) {
    hipLaunchKernelGGL(mega, dim3(grid_blocks), dim3(256), 0, stream, p, s, s + 1);
  }
#else
  int s_lo = 0, s_hi = NSTEPS;
  void* args[] = {&p, &s_lo, &s_hi};
  hipError_t e = hipLaunchCooperativeKernel((void*)mega, dim3(grid_blocks), dim3(256), args, 0, stream);
  if (e != hipSuccess) fprintf(stderr, "coop launch failed: %s (grid %d)\n", hipGetErrorString(e), grid_blocks);
#endif
}
```
